# Optimizing an MI355X kernel written in HIP

```python
import jax
import jax.numpy as jnp
from jax import lax
import numpy as np

D_MODEL = 2048
BATCH = 4
SEQ = 4096
DEPTH = 2

ATTN_HEAD_DIM = 64
ATTN_HEADS = (D_MODEL // 2) // ATTN_HEAD_DIM
ATTN_WIDTH = ATTN_HEADS * ATTN_HEAD_DIM
DILATED_PATTERNS = ((128, 1), (512, 4), (2048, 16))
ATTN_BLOCK = 128
NUM_BUCKETS = 32
REL_MAX_DIST = 2048
MLSTM_HEADS = 4
MLSTM_WIDTH = D_MODEL - ATTN_WIDTH
MLSTM_V_DIM = MLSTM_WIDTH // MLSTM_HEADS
MLSTM_QK_DIM = MLSTM_V_DIM // 2
MLSTM_CHUNK = 128
CONV_WIDTH = 4
MIX_WIDTH = ATTN_WIDTH + MLSTM_WIDTH
IN_SPLITS = (ATTN_WIDTH, ATTN_WIDTH, ATTN_WIDTH,
             MLSTM_HEADS * MLSTM_QK_DIM, MLSTM_HEADS * MLSTM_QK_DIM,
             MLSTM_WIDTH, MLSTM_WIDTH, MLSTM_HEADS, MLSTM_HEADS)
IN_WIDTH = 3 * ATTN_WIDTH + 2 * MLSTM_HEADS * MLSTM_QK_DIM + 2 * MLSTM_WIDTH + 2 * MLSTM_HEADS
MOE_GROUPS = 4
MOE_EXPERTS_PER_GROUP = 8
N_EXPERTS = MOE_GROUPS * MOE_EXPERTS_PER_GROUP
MOE_TOP_K = 2
EXPERT_FF = D_MODEL // 2
MOE_BLOCK = 128
NORM_EPS = 1e-6

kernel_name = "hybrid_dilated_attn_mlstm_hier_moe"


def rms_norm(x, w):
    xf = x.astype(jnp.float32)
    return xf * lax.rsqrt(jnp.mean(xf * xf, axis=-1, keepdims=True) + NORM_EPS) * w.astype(jnp.float32)


def t5_causal_bucket(dist):
    max_exact = NUM_BUCKETS // 2
    d = np.maximum(dist, 1).astype(np.float32)
    large = max_exact + (np.log(d / max_exact) / np.log(REL_MAX_DIST / max_exact)
                         * (NUM_BUCKETS - max_exact)).astype(np.int32)
    large = np.minimum(large, NUM_BUCKETS - 1)
    return np.where(dist < max_exact, dist, large).astype(np.int32)


def dilated_branch(q, k, v, rel_bias, window, dilation):
    B, S, H, dh = q.shape
    L = S // dilation
    win = window // dilation
    blk = ATTN_BLOCK
    nb = -(-L // blk)
    Lp = nb * blk

    def to_strided(t):
        return t.reshape(B, L, dilation, H, dh).transpose(0, 2, 3, 1, 4)

    qs, ks, vs = to_strided(q), to_strided(k), to_strided(v)
    qb = jnp.pad(qs, ((0, 0), (0, 0), (0, 0), (0, Lp - L), (0, 0))).reshape(B, dilation, H, nb, blk, dh)
    kpad = ((0, 0), (0, 0), (0, 0), (blk, Lp - L), (0, 0))
    kb = jnp.pad(ks, kpad).reshape(B, dilation, H, nb + 1, blk, dh)
    vb = jnp.pad(vs, kpad).reshape(B, dilation, H, nb + 1, blk, dh)
    kwin = jnp.concatenate([kb[:, :, :, :-1], kb[:, :, :, 1:]], axis=-2)
    vwin = jnp.concatenate([vb[:, :, :, :-1], vb[:, :, :, 1:]], axis=-2)

    qi = np.arange(blk)[:, None]
    kj = np.arange(2 * blk)[None, :]
    rel = qi - kj + blk
    blk_id = np.arange(nb)[:, None, None]
    valid = (rel >= 0) & (rel <= win) & (blk_id * blk + kj - blk >= 0)
    bucket = t5_causal_bucket(np.clip(rel, 0, win) * dilation)
    bias = jnp.transpose(rel_bias[bucket], (2, 0, 1)).astype(jnp.float32)

    s = jnp.einsum('bdhnqe,bdhnke->bdhnqk', qb, kwin) * (dh ** -0.5) + bias[:, None]
    s = jnp.where(valid, s, -1e30)
    m = jnp.max(s, axis=-1, keepdims=True)
    p = jnp.exp(s - m)
    l = jnp.sum(p, axis=-1, keepdims=True)
    o = jnp.einsum('bdhnqk,bdhnke->bdhnqe', p, vwin) / l
    lse = (m + jnp.log(l))[..., 0]

    o = o.reshape(B, dilation, H, Lp, dh)[:, :, :, :L].transpose(0, 3, 1, 2, 4).reshape(B, S, H, dh)
    lse = lse.reshape(B, dilation, H, Lp)[:, :, :, :L].transpose(0, 3, 1, 2).reshape(B, S, H)
    return o, lse


def dilated_mixture_attention(q, k, v, rel_bias):
    outs, lses = [], []
    for window, dilation in DILATED_PATTERNS:
        o, lse = dilated_branch(q, k, v, rel_bias, window, dilation)
        outs.append(o)
        lses.append(lse)
    alpha = jax.nn.softmax(jnp.stack(lses, axis=0), axis=0)
    return jnp.sum(alpha[..., None] * jnp.stack(outs, axis=0), axis=0)


def causal_depthwise_conv(x, w):
    K, C = w.shape
    return lax.conv_general_dilated(x, w[:, None, :], window_strides=(1,), padding=[(K - 1, 0)],
                                    dimension_numbers=('NWC', 'WIO', 'NWC'), feature_group_count=C)


def mlstm_chunkwise(q, k, v, i_pre, f_pre):
    B, S, H, dk = q.shape
    dv = v.shape[-1]
    ch = MLSTM_CHUNK
    nc = S // ch
    k = k * (dk ** -0.5)

    def chunk(t):
        return t.reshape(B, nc, ch, H, -1).transpose(0, 3, 1, 2, 4)

    qc, kc, vc = chunk(q), chunk(k), chunk(v)
    ig = i_pre.reshape(B, nc, ch, H).transpose(0, 3, 1, 2)
    lf = jax.nn.log_sigmoid(f_pre).reshape(B, nc, ch, H).transpose(0, 3, 1, 2)
    b = jnp.cumsum(lf, axis=-1)
    g = b[..., -1]
    a = g[..., None] - b + ig

    def step(carry, inp):
        C, n, m = carry
        kk, vv, aa, gg = inp
        m_new = jnp.maximum(gg + m, jnp.max(aa, axis=-1))
        decay = jnp.exp(gg + m - m_new)
        w = jnp.exp(aa - m_new[..., None])
        C_new = decay[..., None, None] * C + jnp.einsum('bhsv,bhsk->bhvk', w[..., None] * vv, kk)
        n_new = decay[..., None] * n + jnp.einsum('bhs,bhsk->bhk', w, kk)
        return (C_new, n_new, m_new), (C, n, m)

    init = (jnp.zeros((B, H, dv, dk), jnp.float32), jnp.zeros((B, H, dk), jnp.float32),
            jnp.zeros((B, H), jnp.float32))
    xs = (jnp.moveaxis(kc, 2, 0), jnp.moveaxis(vc, 2, 0), jnp.moveaxis(a, 2, 0), jnp.moveaxis(g, 2, 0))
    _, (Cs, ns, ms) = lax.scan(step, init, xs)
    Cs = jnp.moveaxis(Cs, 0, 2)
    ns = jnp.moveaxis(ns, 0, 2)
    ms = jnp.moveaxis(ms, 0, 2)

    causal = np.tril(np.ones((ch, ch), dtype=bool))
    Dlog = jnp.where(causal, b[..., :, None] - b[..., None, :] + ig[..., None, :], -jnp.inf)
    inter = b + ms[..., None]
    m_t = jnp.maximum(inter, jnp.max(Dlog, axis=-1))
    Sm = jnp.einsum('bhcqd,bhcsd->bhcqs', qc, kc) * jnp.exp(Dlog - m_t[..., None])
    e_inter = jnp.exp(inter - m_t)
    num = (e_inter[..., None] * jnp.einsum('bhcvd,bhcqd->bhcqv', Cs, qc)
           + jnp.einsum('bhcqs,bhcsv->bhcqv', Sm, vc))
    den = e_inter * jnp.einsum('bhcd,bhcqd->bhcq', ns, qc) + jnp.sum(Sm, axis=-1)
    h = num / jnp.maximum(jnp.abs(den), jnp.exp(-m_t))[..., None]
    return h.transpose(0, 2, 3, 1, 4).reshape(B, S, H, dv)


def hybrid_mixer(h, w_in, q_norm_w, k_norm_w, rel_bias, conv_w, gate_b, h_norm_w, w_out):
    B, S, _ = h.shape
    split_idx = np.cumsum(IN_SPLITS)[:-1].tolist()
    aq, ak, av, mq, mk, mv, mo, mi, mf = jnp.split(h @ w_in, split_idx, axis=-1)

    aq = rms_norm(aq.reshape(B, S, ATTN_HEADS, ATTN_HEAD_DIM), q_norm_w)
    ak = rms_norm(ak.reshape(B, S, ATTN_HEADS, ATTN_HEAD_DIM), k_norm_w)
    av = av.reshape(B, S, ATTN_HEADS, ATTN_HEAD_DIM).astype(jnp.float32)
    attn = dilated_mixture_attention(aq, ak, av, rel_bias).reshape(B, S, ATTN_WIDTH)

    qk = jax.nn.silu(causal_depthwise_conv(jnp.concatenate([mq, mk], axis=-1), conv_w)).astype(jnp.float32)
    mq, mk = jnp.split(qk, 2, axis=-1)
    mi = mi.astype(jnp.float32) + gate_b[:MLSTM_HEADS].astype(jnp.float32)
    mf = mf.astype(jnp.float32) + gate_b[MLSTM_HEADS:].astype(jnp.float32)
    hm = mlstm_chunkwise(mq.reshape(B, S, MLSTM_HEADS, MLSTM_QK_DIM), mk.reshape(B, S, MLSTM_HEADS, MLSTM_QK_DIM),
                         mv.reshape(B, S, MLSTM_HEADS, MLSTM_V_DIM).astype(jnp.float32), mi, mf)
    hm = rms_norm(hm, h_norm_w.reshape(MLSTM_HEADS, MLSTM_V_DIM)).reshape(B, S, MLSTM_WIDTH)
    hm = jax.nn.sigmoid(mo.astype(jnp.float32)) * hm

    mixed = jnp.concatenate([attn, hm], axis=-1).astype(h.dtype)
    return mixed @ w_out


def hier_route(ht, wg, bg, we, be):
    T = ht.shape[0]
    lg = (ht @ wg + bg).astype(jnp.float32)
    pg = jax.nn.softmax(lg, axis=-1)
    _, gsel = lax.top_k(lg, 1)
    p_group = jnp.take_along_axis(pg, gsel, axis=-1)
    le = (ht @ we + be).astype(jnp.float32).reshape(T, MOE_GROUPS, MOE_EXPERTS_PER_GROUP)
    le_sel = jnp.take_along_axis(le, gsel[:, :, None], axis=1)[:, 0]
    top_v, top_i = lax.top_k(le_sel, MOE_TOP_K)
    weights = p_group * jax.nn.softmax(top_v, axis=-1)
    expert_idx = gsel * MOE_EXPERTS_PER_GROUP + top_i
    return expert_idx, weights


def hier_moe(h, wg, bg, we, be, w_gate, w_up, w_down):
    B, S, D = h.shape
    T = B * S
    ht = h.reshape(T, D)
    expert_idx, weights = hier_route(ht, wg, bg, we, be)
    A = T * MOE_TOP_K
    flat_e = expert_idx.reshape(A)
    flat_tok = jnp.arange(A, dtype=jnp.int32) // MOE_TOP_K
    order = jnp.argsort(flat_e)
    se, stok, sw = flat_e[order], flat_tok[order], weights.reshape(A)[order]
    counts = jnp.bincount(flat_e, length=N_EXPERTS)
    padded = (counts + MOE_BLOCK - 1) // MOE_BLOCK * MOE_BLOCK
    pad_end = jnp.cumsum(padded)
    pad_start = pad_end - padded
    start = jnp.cumsum(counts) - counts
    dest = pad_start[se] + jnp.arange(A, dtype=jnp.int32) - start[se]
    n_rows = (-(-A // MOE_BLOCK)) * MOE_BLOCK + N_EXPERTS * MOE_BLOCK
    n_blocks = n_rows // MOE_BLOCK
    rows = jnp.zeros((n_rows, D), h.dtype).at[dest].set(ht[stok])
    block_e = jnp.minimum(jnp.searchsorted(pad_end, jnp.arange(n_blocks, dtype=jnp.int32) * MOE_BLOCK,
                                           side='right'), N_EXPERTS - 1)

    def expert_block(args):
        xb, e = args
        return (jax.nn.silu(xb @ w_gate[e]) * (xb @ w_up[e])) @ w_down[e]

    out_rows = lax.map(expert_block, (rows.reshape(n_blocks, MOE_BLOCK, D), block_e)).reshape(n_rows, D)
    y = jnp.zeros((T, D), jnp.float32).at[stok].add(out_rows[dest].astype(jnp.float32) * sw[:, None])
    return y.reshape(B, S, D)


def setup_inputs(seed: int = 0) -> dict:
    key = jax.random.key(seed)
    ks = jax.random.split(key, 24)
    f32 = jnp.float32

    def nrm(k, shape, std):
        return jax.random.normal(k, shape, f32) * std

    gate_b = jnp.concatenate([
        nrm(ks[11], (DEPTH, MLSTM_HEADS), 0.1),
        jnp.linspace(3.0, 6.0, MLSTM_HEADS, dtype=f32)[None, :] + nrm(ks[12], (DEPTH, MLSTM_HEADS), 0.1)],
        axis=-1)
    return {
        'x': nrm(ks[0], (BATCH, SEQ, D_MODEL), 1.0),
        'c': nrm(ks[1], (BATCH, D_MODEL), 1.0),
        'rel_bias': nrm(ks[2], (NUM_BUCKETS, ATTN_HEADS), 0.5),
        'w_mod': nrm(ks[3], (DEPTH, D_MODEL, 6 * D_MODEL), D_MODEL ** -0.5),
        'b_mod': nrm(ks[4], (DEPTH, 6 * D_MODEL), 0.02),
        'norm1_w': 1.0 + nrm(ks[5], (DEPTH, D_MODEL), 0.02),
        'norm2_w': 1.0 + nrm(ks[6], (DEPTH, D_MODEL), 0.02),
        'w_in': nrm(ks[7], (DEPTH, D_MODEL, IN_WIDTH), D_MODEL ** -0.5),
        'q_norm_w': 1.0 + nrm(ks[8], (DEPTH, ATTN_HEAD_DIM), 0.02),
        'k_norm_w': 1.0 + nrm(ks[9], (DEPTH, ATTN_HEAD_DIM), 0.02),
        'conv_w': nrm(ks[10], (DEPTH, CONV_WIDTH, 2 * MLSTM_HEADS * MLSTM_QK_DIM), CONV_WIDTH ** -0.5),
        'gate_b': gate_b,
        'h_norm_w': 1.0 + nrm(ks[13], (DEPTH, MLSTM_WIDTH), 0.02),
        'w_out': nrm(ks[14], (DEPTH, MIX_WIDTH, D_MODEL), MIX_WIDTH ** -0.5),
        'router_group_w': nrm(ks[15], (DEPTH, D_MODEL, MOE_GROUPS), D_MODEL ** -0.5),
        'router_group_b': nrm(ks[16], (DEPTH, MOE_GROUPS), 0.01),
        'router_expert_w': nrm(ks[17], (DEPTH, D_MODEL, N_EXPERTS), D_MODEL ** -0.5),
        'router_expert_b': nrm(ks[18], (DEPTH, N_EXPERTS), 0.01),
        'w_gate': nrm(ks[19], (DEPTH, N_EXPERTS, D_MODEL, EXPERT_FF), D_MODEL ** -0.5),
        'w_up': nrm(ks[20], (DEPTH, N_EXPERTS, D_MODEL, EXPERT_FF), D_MODEL ** -0.5),
        'w_down': nrm(ks[21], (DEPTH, N_EXPERTS, EXPERT_FF, D_MODEL), EXPERT_FF ** -0.5),
    }


def reference(x, c, rel_bias, w_mod, b_mod, norm1_w, norm2_w, w_in, q_norm_w, k_norm_w, conv_w,
              gate_b, h_norm_w, w_out, router_group_w, router_group_b, router_expert_w,
              router_expert_b, w_gate, w_up, w_down):
    B, S, D = x.shape
    for l in range(DEPTH):
        mod = (jax.nn.silu(c) @ w_mod[l] + b_mod[l]).astype(jnp.float32).reshape(B, 6, 1, D)
        shift1, scale1, gate1 = mod[:, 0], mod[:, 1], mod[:, 2]
        shift2, scale2, gate2 = mod[:, 3], mod[:, 4], mod[:, 5]

        h = (rms_norm(x, norm1_w[l]) * (1.0 + scale1) + shift1).astype(x.dtype)
        mix = hybrid_mixer(h, w_in[l], q_norm_w[l], k_norm_w[l], rel_bias, conv_w[l], gate_b[l],
                           h_norm_w[l], w_out[l])
        x = x + (gate1 * mix.astype(jnp.float32)).astype(x.dtype)

        h = (rms_norm(x, norm2_w[l]) * (1.0 + scale2) + shift2).astype(x.dtype)
        ffn = hier_moe(h, router_group_w[l], router_group_b[l], router_expert_w[l], router_expert_b[l],
                       w_gate[l], w_up[l], w_down[l])
        x = x + (gate2 * ffn).astype(x.dtype)
    return x
```

```cpp
#include <hip/hip_runtime.h>
#include <cstdio>
#include <cstdint>
#ifndef PG8_WGM
#define PG8_WGM 4
#endif
namespace pg8 {
#define PG8_LAS __attribute__((address_space(3)))
typedef unsigned short bf16_t;
typedef short bf16x8 __attribute__((ext_vector_type(8)));
typedef float f32x4 __attribute__((ext_vector_type(4)));
typedef unsigned u32x4 __attribute__((ext_vector_type(4)));
constexpr int BM = 256, BK = 64, HALF = 128, HTB = HALF * BK * 2  , STAGE_BYTES = 8 * HTB, NXCD = 8, WGM = PG8_WGM;

__host__ __device__ __forceinline__ int lds_byte(int r, int c) { const int st = (r >> 4) * 2 + (c >> 5), rr = r & 15, cc = c & 31, ob = rr * 64 + cc * 2; return st * 1024 + (ob ^ (((ob >> 9) & 1) << 5)); }
__host__ __device__ __forceinline__ void stage_rc(int b, int& R, int& C) { const int st = b / 1024, sb = b % 1024, swz = sb ^ (((sb >> 9) & 1) << 5); R = (st >> 1) * 16 + swz / 64; C = (st & 1) * 32 + (swz % 64) / 2; }
__host__ __device__ __forceinline__ int perm32(int rho) { const int n = rho >> 4, i = rho & 15; return 8 * (i >> 2) + 4 * n + (i & 3); }

struct Unit { int pm, pn; };
struct Gemm { const bf16_t* A; const bf16_t* Bt; int M, N, K; const int* rt = nullptr; };

struct StaticOrder {
    int nM, nN, nwg, G, c;
    __host__ __device__ void init(int M, int N, int G_, int c_) { nM = M / BM; nN = N / BM; nwg = nM * nN; G = G_; c = c_; }
    __host__ __device__ bool next(int i, Unit& u) const {
        const long L = (long)i * G + c; if (L >= nwg) return false;
        int wgid = (int)L; { const int q = nwg / NXCD, r = nwg % NXCD, xcd = wgid % NXCD, off = wgid / NXCD; wgid = (xcd < r ? xcd * (q + 1) : r * (q + 1) + (xcd - r) * q) + off; }
        const int nig = WGM * nN, gid = wgid / nig, fm = gid * WGM, gsz = (nM - fm) < WGM ? (nM - fm) : WGM;
        u.pm = fm + ((wgid % nig) % gsz); u.pn = (wgid % nig) / gsz; return true;
    }
    __device__ __forceinline__ void a_ready(const Unit&) const {}
    __device__ __forceinline__ void done(const Unit&) const {}
};

__device__ __forceinline__ unsigned cvt_pk_bf16(float lo, float hi) { unsigned r; asm volatile("v_cvt_pk_bf16_f32 %0, %1, %2" : "=v"(r) : "v"(lo), "v"(hi)); return r; }
typedef float f32x2 __attribute__((ext_vector_type(2)));
__device__ __forceinline__ f32x2 gelu_pk(f32x2 v) {
    const f32x2 av = __builtin_elementwise_abs(v), d = av * 0.2316418882f + 1.0f;
    f32x2 t; t.x = __builtin_amdgcn_rcpf(d.x); t.y = __builtin_amdgcn_rcpf(d.y);
    f32x2 q = t * 0.5307027145f + (-0.7265760135f); q = q * t + 0.7107068705f; q = q * t + (-0.142248368f); q = q * t + 0.127414796f; q = q * t;
    const f32x2 s = (v * v) * (-0.72134752044f);
    f32x2 e; e.x = __builtin_amdgcn_exp2f(s.x); e.y = __builtin_amdgcn_exp2f(s.y);
    const f32x2 m = v * (q * e), r = v - m;
    f32x2 o; o.x = v.x < 0.f ? m.x : r.x; o.y = v.y < 0.f ? m.y : r.y; return o;
}

template <int ACT  > struct EpiBf16 {
    static constexpr bool PERM = true, AFTER_DRAIN = false; static_assert(ACT == 0 || ACT == 1, "EpiBf16: ACT is 0 (none) or 1 (gelu_pk)");
    bf16_t* O; int ldc; const float* bias; int split_cols; size_t split_stride; float scale0;
    __device__ __forceinline__ void operator()(const f32x4 (&acc)[2][2][4][2], const Unit& u, int wr, int wc, int fr, int fq) const {
        const int row0 = u.pm * BM + wr * 64 + fr; int colt = u.pn * BM; bf16_t* base = O;
        float sc = 1.f; if (split_cols) { const int t = colt / split_cols; base += (size_t)t * split_stride; colt -= t * split_cols; if (t == 0) sc = scale0; }
        const int col0 = colt + wc * 32 + 8 * fq, bcol0 = u.pn * BM + wc * 32 + 8 * fq;
        f32x4 bv[2][2];
#pragma unroll
        for (int bj = 0; bj < 2; ++bj)
#pragma unroll
            for (int n = 0; n < 2; ++n) bv[bj][n] = bias ? *(const f32x4*)(bias + bcol0 + bj * HALF + 4 * n) : (f32x4){0.f, 0.f, 0.f, 0.f};
#pragma unroll
        for (int ai = 0; ai < 2; ++ai)
#pragma unroll
            for (int m = 0; m < 4; ++m) { bf16_t* rowp = base + (size_t)(row0 + ai * HALF + m * 16) * ldc + col0;
#pragma unroll
                for (int bj = 0; bj < 2; ++bj) { f32x4 v0 = acc[ai][bj][m][0] + bv[bj][0], v1 = acc[ai][bj][m][1] + bv[bj][1];
                    if (ACT == 1) { f32x2 a = gelu_pk((f32x2){v0[0], v0[1]}), b = gelu_pk((f32x2){v0[2], v0[3]}), c = gelu_pk((f32x2){v1[0], v1[1]}), d = gelu_pk((f32x2){v1[2], v1[3]});
                        v0 = (f32x4){a.x, a.y, b.x, b.y}; v1 = (f32x4){c.x, c.y, d.x, d.y}; }
                    v0 = v0 * sc; v1 = v1 * sc; u32x4 w; w.x = cvt_pk_bf16(v0[0], v0[1]); w.y = cvt_pk_bf16(v0[2], v0[3]); w.z = cvt_pk_bf16(v1[0], v1[1]); w.w = cvt_pk_bf16(v1[2], v1[3]);
                    *(u32x4*)(rowp + bj * HALF) = w; } }
    }
};
template <class Epi, class Sched, bool ALIGN_EPI = false, bool SP2 = false, bool GATHER = false>
__device__ __forceinline__ void gemm_phase(PG8_LAS unsigned char* lds, const Gemm g, const Sched& S, const Epi& E) {
    int tid_ = threadIdx.x; asm volatile("" : "+v"(tid_));
    const int tid = tid_, wid = __builtin_amdgcn_readfirstlane(tid >> 6), lane = tid & 63, wr = wid >> 2, wc = wid & 3, fr = lane & 15, fq = lane >> 4;
    const int K = g.K, nt = K / BK;
    unsigned voffA[2], voffB[2]; int Rr[2], Cc[2];
#pragma unroll
    for (int i = 0; i < 2; ++i) { int R, C; stage_rc(tid * 16 + i * 8192, R, C); const int Rb = Epi::PERM ? ((R & ~31) + perm32(R & 31)) : R; Rr[i] = R; Cc[i] = C;
        voffA[i] = (unsigned)(R * K + C) * 2u; voffB[i] = (unsigned)(Rb * K + C) * 2u; }
    unsigned gC[2][2] = {{0u, 0u}, {0u, 0u}}, gN[2][2] = {{0u, 0u}, {0u, 0u}};
#define PG8_GOFF(dst, U) do { _Pragma("unroll") for (int h_ = 0; h_ < 2; ++h_) _Pragma("unroll") for (int i_ = 0; i_ < 2; ++i_) \
        dst[h_][i_] = (unsigned)(g.rt[(U).pm * BM + h_ * HALF + Rr[i_]] * K + Cc[i_]) * 2u; } while (0)
#define PG8_STAGE_A(bufoff, p, h, nx) do { if constexpr (GATHER) { const unsigned vo_[2] = {(nx) ? gN[h][0] : gC[h][0], (nx) ? gN[h][1] : gC[h][1]}; PG8_STAGE(bufoff, p, vo_); } \
        else { PG8_STAGE(bufoff, (p) + (h) * hstep, voffA); } } while (0)
    const size_t kstep = (size_t)(BK * 2);
    const size_t hstep = (size_t)HALF * K * 2;
    const size_t tstep = 2 * hstep;
    const unsigned ldsw = (unsigned)wid * 1024u;
    const int aoff = lds_byte(wr * 64 + fr, fq * 8), boff = lds_byte(wc * 32 + fr, fq * 8);
#define PG8_SA(b, h) (((b) * 2 + (h)) * HTB)
#define PG8_SB(b, h) ((4 + (b) * 2 + (h)) * HTB)
#define PG8_STAGE(bufoff, gbase, voff) do { _Pragma("unroll") for (int _i = 0; _i < 2; ++_i) \
        __builtin_amdgcn_global_load_lds((const unsigned*)((const char*)(gbase) + (voff)[_i]), (PG8_LAS unsigned*)(lds + (bufoff) + ldsw + _i * 8192), 16, 0, 0); } while (0)
#define PG8_LDA(dst, b, h) do { _Pragma("unroll") for (int m = 0; m < 4; ++m) _Pragma("unroll") for (int k = 0; k < 2; ++k) dst[m][k] = *(const PG8_LAS bf16x8*)(lds + PG8_SA(b, h) + aoff + m * 2048 + k * 1024); } while (0)
#define PG8_LDB(dst, b, h) do { _Pragma("unroll") for (int n = 0; n < 2; ++n) _Pragma("unroll") for (int k = 0; k < 2; ++k) dst[n][k] = *(const PG8_LAS bf16x8*)(lds + PG8_SB(b, h) + boff + n * 2048 + k * 1024); } while (0)
#define PG8_MMA(ai, bj, At, Bt) do { __builtin_amdgcn_s_setprio(1); _Pragma("unroll") for (int m = 0; m < 4; ++m) _Pragma("unroll") for (int n = 0; n < 2; ++n) _Pragma("unroll") for (int k = 0; k < 2; ++k) \
        acc[ai][bj][m][n] = __builtin_amdgcn_mfma_f32_16x16x32_bf16(Bt[n][k], At[m][k], acc[ai][bj][m][n], 0, 0, 0); __builtin_amdgcn_s_setprio(0); } while (0)
#define PG8_WAIT_V(n) asm volatile("s_waitcnt vmcnt(" #n ")" ::: "memory")
#define PG8_WAIT_L(n) asm volatile("s_waitcnt lgkmcnt(" #n ")" ::: "memory")
#define PG8_BAR __builtin_amdgcn_s_barrier()
#define PG8_SCHED __builtin_amdgcn_sched_barrier(0)
    Unit cur, nxt; int ui = 0;
    if (!S.next(0, cur)) return;
    f32x4 acc[2][2][4][2];
#pragma unroll
    for (int a = 0; a < 2; ++a)
#pragma unroll
        for (int b = 0; b < 2; ++b)
#pragma unroll
            for (int m = 0; m < 4; ++m)
#pragma unroll
                for (int n = 0; n < 2; ++n) acc[a][b][m][n] = (f32x4){0.f, 0.f, 0.f, 0.f};
    bf16x8 At[4][2], B0[2][2], B1[2][2];
    const char* cA = (const char*)g.A + (GATHER ? (size_t)0 : (size_t)cur.pm * tstep); const char* cB = (const char*)g.Bt + (size_t)cur.pn * tstep;
    S.a_ready(cur);
    if constexpr (GATHER) { PG8_GOFF(gC, cur); asm volatile("s_waitcnt vmcnt(0)" ::: "memory"); }
    if constexpr (SP2) {
        PG8_STAGE(PG8_SB(0, 0), cB, voffB); PG8_STAGE(PG8_SB(0, 1), cB + hstep, voffB); PG8_STAGE_A(PG8_SA(0, 0), cA, 0, false); PG8_STAGE_A(PG8_SA(0, 1), cA, 1, false);
        if (wr == 1) PG8_BAR;
        PG8_WAIT_V(2); PG8_BAR;
        PG8_STAGE(PG8_SB(1, 0), cB + kstep, voffB); PG8_STAGE_A(PG8_SA(1, 0), cA + kstep, 0, false); PG8_STAGE(PG8_SB(1, 1), cB + hstep + kstep, voffB);
        PG8_WAIT_V(6); PG8_BAR;
    } else {
        PG8_STAGE(PG8_SB(0, 0), cB, voffB); PG8_STAGE(PG8_SA(0, 0), cA, voffA); PG8_STAGE(PG8_SB(0, 1), cB + hstep, voffB); PG8_STAGE(PG8_SA(0, 1), cA + hstep, voffA);
        if (wr == 1) PG8_BAR;
        PG8_WAIT_V(4); PG8_BAR;
        PG8_STAGE(PG8_SB(1, 0), cB + kstep, voffB); PG8_STAGE(PG8_SA(1, 0), cA + kstep, voffA); PG8_STAGE(PG8_SB(1, 1), cB + hstep + kstep, voffB);
        PG8_WAIT_V(6); PG8_BAR;
    }
    for (;;) {
        const bool has_next = S.next(ui + 1, nxt);
        if constexpr (GATHER) { if (has_next) { PG8_GOFF(gN, nxt); asm volatile("s_waitcnt vmcnt(0)" ::: "memory"); } }
        const char* nA = (has_next && !GATHER) ? (const char*)g.A + (size_t)nxt.pm * tstep : cA; const char* nB = has_next ? (const char*)g.Bt + (size_t)nxt.pn * tstep : cB;
        for (int t = 0; t < nt; t += 2) {
            const bool last = (t == nt - 2);
            const char* a1 = cA + (size_t)(t + 1) * kstep;
            const char* a2 = last ? nA : cA + (size_t)(t + 2) * kstep; const char* b2 = last ? nB : cB + (size_t)(t + 2) * kstep;
            const char* a3 = a2 + kstep; const char* b3 = b2 + kstep;
            const bool nxu = last && has_next;
            if (last && has_next) S.a_ready(nxt);
            if constexpr (SP2) {
            PG8_LDB(B0, 0, 0); PG8_LDB(B1, 0, 1); PG8_SCHED; PG8_LDA(At, 0, 0); PG8_STAGE_A(PG8_SA(1, 1), a1, 1, false);
            PG8_WAIT_V(8); PG8_WAIT_L(0); PG8_BAR; PG8_MMA(0, 0, At, B0); PG8_MMA(0, 1, At, B1); PG8_BAR; PG8_SCHED;
            PG8_LDA(At, 0, 1); PG8_STAGE(PG8_SB(0, 0), b2, voffB); PG8_STAGE(PG8_SB(0, 1), b2 + hstep, voffB); PG8_STAGE_A(PG8_SA(0, 0), a2, 0, nxu);
            PG8_WAIT_V(8); PG8_WAIT_L(0); PG8_BAR; PG8_MMA(1, 0, At, B0); PG8_MMA(1, 1, At, B1); PG8_BAR; PG8_SCHED;
            PG8_LDB(B0, 1, 0); PG8_LDB(B1, 1, 1); PG8_SCHED; PG8_LDA(At, 1, 0); PG8_STAGE_A(PG8_SA(0, 1), a2, 1, nxu);
            PG8_WAIT_V(8); PG8_WAIT_L(0); PG8_BAR; PG8_MMA(0, 0, At, B0); PG8_MMA(0, 1, At, B1); PG8_BAR; PG8_SCHED;
            PG8_LDA(At, 1, 1); PG8_STAGE(PG8_SB(1, 0), b3, voffB); PG8_STAGE(PG8_SB(1, 1), b3 + hstep, voffB); PG8_STAGE_A(PG8_SA(1, 0), a3, 0, nxu);
            PG8_WAIT_V(8); PG8_WAIT_L(0); PG8_BAR; PG8_MMA(1, 0, At, B0); PG8_MMA(1, 1, At, B1); PG8_BAR; PG8_SCHED;
            } else {
            PG8_LDB(B0, 0, 0); PG8_SCHED; PG8_LDA(At, 0, 0); PG8_STAGE(PG8_SA(1, 1), a1 + hstep, voffA);
            PG8_WAIT_L(8); PG8_BAR; PG8_WAIT_L(0); PG8_MMA(0, 0, At, B0); PG8_BAR; PG8_SCHED;
            PG8_LDB(B1, 0, 1); PG8_STAGE(PG8_SB(0, 0), b2, voffB);
            PG8_BAR; PG8_WAIT_L(0); PG8_MMA(0, 1, At, B1); PG8_BAR;
            PG8_LDA(At, 0, 1); PG8_STAGE(PG8_SA(0, 0), a2, voffA);
            PG8_BAR; PG8_WAIT_L(0); PG8_MMA(1, 0, At, B0); PG8_BAR; PG8_SCHED;
            PG8_STAGE(PG8_SB(0, 1), b2 + hstep, voffB);
            PG8_WAIT_V(6); PG8_BAR; PG8_MMA(1, 1, At, B1); PG8_BAR;
            PG8_LDB(B0, 1, 0); PG8_SCHED; PG8_LDA(At, 1, 0); PG8_STAGE(PG8_SA(0, 1), a2 + hstep, voffA);
            PG8_WAIT_L(8); PG8_BAR; PG8_WAIT_L(0); PG8_MMA(0, 0, At, B0); PG8_BAR; PG8_SCHED;
            PG8_LDB(B1, 1, 1); PG8_STAGE(PG8_SB(1, 0), b3, voffB);
            PG8_BAR; PG8_WAIT_L(0); PG8_MMA(0, 1, At, B1); PG8_BAR;
            PG8_LDA(At, 1, 1); PG8_STAGE(PG8_SA(1, 0), a3, voffA);
            PG8_BAR; PG8_WAIT_L(0); PG8_MMA(1, 0, At, B0); PG8_BAR; PG8_SCHED;
            PG8_STAGE(PG8_SB(1, 1), b3 + hstep, voffB);
            PG8_WAIT_V(6); PG8_BAR; PG8_MMA(1, 1, At, B1); PG8_BAR;
            }
        }
        if constexpr (ALIGN_EPI) { if (wr == 0) PG8_BAR; }
        if constexpr (!Epi::AFTER_DRAIN) { E(acc, cur, wr, wc, fr, fq); S.done(cur); }
        if (!has_next) break;
#pragma unroll
        for (int a = 0; a < 2; ++a)
#pragma unroll
            for (int b = 0; b < 2; ++b)
#pragma unroll
                for (int m = 0; m < 4; ++m)
#pragma unroll
                    for (int n = 0; n < 2; ++n) acc[a][b][m][n] = (f32x4){0.f, 0.f, 0.f, 0.f};
        cur = nxt; cA = nA; cB = nB; ++ui;
        if constexpr (GATHER) { _Pragma("unroll") for (int h_ = 0; h_ < 2; ++h_) _Pragma("unroll") for (int i_ = 0; i_ < 2; ++i_) gC[h_][i_] = gN[h_][i_]; }
        if constexpr (ALIGN_EPI) { if (wr == 1) PG8_BAR; }
    }
    PG8_WAIT_V(0);
    if constexpr (!ALIGN_EPI) { if (wr == 0) PG8_BAR; }
    PG8_BAR;
    if constexpr (Epi::AFTER_DRAIN) { E.fused(acc, cur, wr, wc, fr, fq, lds, wid, lane); S.done(cur); }
#undef PG8_SA
#undef PG8_GOFF
#undef PG8_STAGE_A
#undef PG8_SB
#undef PG8_STAGE
#undef PG8_LDA
#undef PG8_LDB
#undef PG8_MMA
#undef PG8_WAIT_V
#undef PG8_WAIT_L
#undef PG8_BAR
#undef PG8_SCHED
}
}

constexpr int NB = 4, SEQ = 4096, DM = 2048, T = NB * SEQ, NLAYER = 2;
constexpr int INW = 6152, NPROJ = 6144;
constexpr int C_AQ = 0, C_AK = 1024, C_AV = 2048, C_MQ = 3072, C_MK = 3584, C_MV = 4096, C_MO = 5120;
constexpr int NEXP = 32, FFE = 1024;
constexpr int MODW = 6 * DM;
constexpr float EPS = 1e-6f;
constexpr int MAXTILES = 160;
constexpr int HS_ROWS = MAXTILES * 256;
constexpr int NWAVES = 8, NTHR = 512;

constexpr size_t MiB = 1u << 20;
constexpr size_t WS_CTL = 0, CTL_ZERO_BYTES = 1 * MiB;
constexpr size_t WS_MOD = 1 * MiB;
constexpr size_t WS_GATES = 2 * MiB;
constexpr size_t WS_BCUM = 3 * MiB;
constexpr size_t WS_SMALL = 4 * MiB;
constexpr size_t WS_TOK = 5 * MiB;
constexpr size_t WS_NLOC = 6 * MiB;
constexpr size_t WS_NS = 7 * MiB;
constexpr size_t WS_ROWTOK = 7 * MiB + 512 * 1024;
constexpr size_t WS_WIN = 8 * MiB;
constexpr size_t WS_WOUT = 56 * MiB;
constexpr size_t WS_WGU = 72 * MiB;
constexpr size_t WS_WD = 584 * MiB;
constexpr size_t WS_H = 840 * MiB;
constexpr size_t WS_PROJ = 904 * MiB;
constexpr size_t WS_QKC = 1096 * MiB;
constexpr size_t WS_MIXED = 1128 * MiB;
constexpr size_t WS_CL = 1192 * MiB;
constexpr size_t WS_CS = 1256 * MiB;
constexpr size_t WS_HS = 1288 * MiB;
constexpr size_t WS_ACT = 1448 * MiB;
constexpr size_t WS_OROWS = 1528 * MiB;
constexpr size_t WS_KH = 1688 * MiB;
constexpr size_t WS_VH = 1720 * MiB;
constexpr size_t WS_QN = 1752 * MiB;
constexpr size_t WS_END = 1784 * MiB;
constexpr size_t SM_CG = 0, SM_CM = 4096, SM_MS = 8192;
constexpr size_t SM_HIST = 16384;
constexpr size_t SM_TILE = 65536;
constexpr size_t SM_BTG = 917504;
constexpr size_t SM_WRT = 131072;
constexpr size_t TK_E = 0, TK_W = 128 * 1024, TK_R = 256 * 1024, TK_D = 384 * 1024;
constexpr int CW_BAR = 4096;

constexpr int RING_BYTES = 131072;
constexpr int LDS_BYTES = 147456;
constexpr int LDS_PERSIST = LDS_BYTES - 512;
constexpr int LDS_BARW = LDS_PERSIST;
constexpr int LDS_TILE = LDS_PERSIST + 64;
constexpr int LDS_NT = LDS_PERSIST + 256;

#define GAS __attribute__((address_space(1)))
#define LAS __attribute__((address_space(3)))
#define DI __device__ __forceinline__
typedef unsigned short bf16;
typedef unsigned v4u __attribute__((ext_vector_type(4)));
typedef unsigned v2u __attribute__((ext_vector_type(2)));
typedef float f32x4 __attribute__((ext_vector_type(4)));
typedef short bf16x8 __attribute__((ext_vector_type(8)));
typedef short s16x4 __attribute__((ext_vector_type(4)));
typedef GAS unsigned gu32;
#define RLX_AGENT __ATOMIC_RELAXED, __HIP_MEMORY_SCOPE_AGENT
#define LDS_WAIT() asm volatile("s_waitcnt lgkmcnt(0)" ::: "memory")
#define VM_WAIT() asm volatile("s_waitcnt vmcnt(0)" ::: "memory")
DI unsigned f2bf(float f) { unsigned u = __builtin_bit_cast(unsigned, f); return (u + 0x7fffu + ((u >> 16) & 1u)) >> 16; }
typedef float f32x2_t __attribute__((ext_vector_type(2))); typedef __bf16 bf16x2_t __attribute__((ext_vector_type(2)));
DI unsigned pk2(float lo, float hi) { f32x2_t v = {lo, hi}; bf16x2_t b = __builtin_convertvector(v, bf16x2_t); return __builtin_bit_cast(unsigned, b); }
DI float bf2f(unsigned v) { return __builtin_bit_cast(float, v << 16); }
DI float bflo(unsigned w) { return __builtin_bit_cast(float, w << 16); }
DI float bfhi(unsigned w) { return __builtin_bit_cast(float, w & 0xffff0000u); }
DI float wave_sum(float v) {
#pragma unroll
    for (int o = 1; o < 64; o <<= 1) v += __shfl_xor(v, o);
    return v;
}
DI float wave_max(float v) {
#pragma unroll
    for (int o = 1; o < 64; o <<= 1) v = fmaxf(v, __shfl_xor(v, o));
    return v;
}
DI float sigmoidf_(float x) { return 1.f / (1.f + __expf(-x)); }
DI float siluf_(float x) { return x / (1.f + __expf(-x)); }
DI float logsigmoidf_(float x) { return x >= 0.f ? -log1pf(expf(-x)) : x - log1pf(expf(x)); }
DI bf16x8 mk8(s16x4 a, s16x4 b) { bf16x8 r; r[0] = a[0]; r[1] = a[1]; r[2] = a[2]; r[3] = a[3]; r[4] = b[0]; r[5] = b[1]; r[6] = b[2]; r[7] = b[3]; return r; }
DI s16x4 tr_read(const LAS bf16* p) { typedef short v4i16_t __attribute__((ext_vector_type(4))); return __builtin_bit_cast(s16x4, __builtin_amdgcn_ds_read_tr16_b64_v4i16((LAS v4i16_t*)p)); }
#define MFMA16(a, b, c) __builtin_amdgcn_mfma_f32_16x16x32_bf16((a), (b), (c), 0, 0, 0)

__device__ const unsigned char BUCKET[3][132] = {
 {0,1,2,3,4,5,6,7,8,9,10,11,12,13,14,15,16,16,16,16,16,16,17,17,17,17,17,17,17,17,18,18,18,18,18,18,18,18,18,18,19,19,19,19,19,19,19,19,19,19,19,19,19,19,20,20,20,20,20,20,20,20,20,20,20,20,20,20,20,20,20,20,20,21,21,21,21,21,21,21,21,21,21,21,21,21,21,21,21,21,21,21,21,21,21,21,21,21,21,22,22,22,22,22,22,22,22,22,22,22,22,22,22,22,22,22,22,22,22,22,22,22,22,22,22,22,22,22,22,0,0,0},
 {0,4,8,12,16,16,17,17,18,18,19,19,19,19,20,20,20,20,20,21,21,21,21,21,21,22,22,22,22,22,22,22,22,22,23,23,23,23,23,23,23,23,23,23,23,23,24,24,24,24,24,24,24,24,24,24,24,24,24,24,24,24,25,25,25,25,25,25,25,25,25,25,25,25,25,25,25,25,25,25,25,25,25,26,26,26,26,26,26,26,26,26,26,26,26,26,26,26,26,26,26,26,26,26,26,26,26,26,26,26,26,26,26,27,27,27,27,27,27,27,27,27,27,27,27,27,27,27,27,0,0,0},
 {0,16,18,19,20,21,21,22,22,23,23,23,24,24,24,24,25,25,25,25,25,26,26,26,26,26,26,26,26,27,27,27,27,27,27,27,27,27,27,28,28,28,28,28,28,28,28,28,28,28,28,28,29,29,29,29,29,29,29,29,29,29,29,29,29,29,29,29,29,29,30,30,30,30,30,30,30,30,30,30,30,30,30,30,30,30,30,30,30,30,30,30,30,30,30,31,31,31,31,31,31,31,31,31,31,31,31,31,31,31,31,31,31,31,31,31,31,31,31,31,31,31,31,31,31,31,31,31,31,0,0,0}};
#define XB_TMO      128
#define XB_XCNT(j)  (256  + 64 * (j))
#define XB_XSUB(j)  (1280 + 64 * (j))
#define XB_XGEN(j)  (2304 + 64 * (j))
#define XB_TOP      3328
#define XB_TOPGEN   3392
#define XCD_BAR_WORDS 3456
#define XB_SPIN_CAP (1u << 18)

__device__ __forceinline__ unsigned xb_ld(unsigned* p)              { return __hip_atomic_load(p, __ATOMIC_RELAXED, __HIP_MEMORY_SCOPE_AGENT); }
__device__ __forceinline__ unsigned xb_add(unsigned* p, unsigned v) { return __hip_atomic_fetch_add(p, v, __ATOMIC_RELAXED, __HIP_MEMORY_SCOPE_AGENT); }
__device__ __forceinline__ unsigned xb_xcc_id() { return (unsigned)__builtin_amdgcn_s_getreg((3 << 11) | 20) & 0xFu; }
#define XB_SPIN(cond, bar) do { unsigned _sp = 0; while (cond) { __builtin_amdgcn_s_sleep(1); \
    if ((++_sp & 255u) == 0u) { if (xb_ld(&(bar)[XB_TMO])) break; if (_sp > XB_SPIN_CAP) { atomicAdd(&(bar)[XB_TMO], 1u); break; } } } } while (0)

struct XcdBarrier {
    unsigned* bar; unsigned x;
    volatile LAS unsigned* st;
};

__device__ __forceinline__ XcdBarrier xcd_barrier_post(unsigned* bar, volatile LAS unsigned* st) {
    XcdBarrier b; b.bar = bar; b.x = xb_xcc_id(); b.st = st;
    if (threadIdx.x == 0) (void)xb_add(&bar[XB_XCNT(b.x)], 1u);
    return b;
}
__device__ __forceinline__ void xcd_barrier_complete(unsigned* bar, unsigned x, unsigned& nloc, unsigned& nx) {
    const unsigned G = gridDim.x * gridDim.y * gridDim.z;
    unsigned sum, cnt, mine, sp = 0u;
    for (;;) {
        sum = 0u; cnt = 0u; mine = 0u;
#pragma unroll
        for (unsigned j = 0; j < 16; ++j) { const unsigned c = xb_ld(&bar[XB_XCNT(j)]); sum += c; cnt += (c > 0u) ? 1u : 0u; mine = (j == x) ? c : mine; }
        if (sum == G) break;
        __builtin_amdgcn_s_sleep(1);
        if ((++sp & 255u) == 0u) { if (xb_ld(&bar[XB_TMO])) break; if (sp > XB_SPIN_CAP) { atomicAdd(&bar[XB_TMO], 1u); break; } }
    }
    nloc = mine > 0u ? mine : 1u; nx = cnt > 0u ? cnt : 1u;
}

__device__ __forceinline__ void xcd_barrier(const XcdBarrier& b) {
    asm volatile("s_waitcnt vmcnt(0)" ::: "memory");
    __syncthreads();
    if (threadIdx.x == 0) {
        unsigned* bar = b.bar;
        __builtin_amdgcn_s_waitcnt(0);
        unsigned nloc = b.st[0], nx = b.st[1];
        if (nloc == 0u) { xcd_barrier_complete(bar, b.x, nloc, nx); b.st[0] = nloc; b.st[1] = nx; }
        const unsigned old = xb_add(&bar[XB_XSUB(b.x)], 1u);
        const unsigned gen = old / nloc;
        if (old + 1u == (gen + 1u) * nloc) {
            __builtin_amdgcn_fence(__ATOMIC_RELEASE, "agent");
            asm volatile("s_waitcnt vmcnt(0)" ::: "memory");
            const unsigned og = xb_add(&bar[XB_TOP], 1u);
            const unsigned tg = og / nx;
            if (og + 1u == (tg + 1u) * nx) xb_add(&bar[XB_TOPGEN], 1u);
            else XB_SPIN(xb_ld(&bar[XB_TOPGEN]) == tg, bar);
            __builtin_amdgcn_fence(__ATOMIC_ACQUIRE, "agent");
            xb_add(&bar[XB_XGEN(b.x)], 1u);
            asm volatile("s_waitcnt vmcnt(0)" ::: "memory");
        } else {
            XB_SPIN(xb_ld(&bar[XB_XGEN(b.x)]) == gen, bar);
            __builtin_amdgcn_fence(__ATOMIC_ACQUIRE, "agent");
            asm volatile("s_waitcnt vmcnt(0)" ::: "memory");
        }
    }
    __syncthreads();
}

DI void p0_mod(const float* c, const float* w_mod, const float* b_mod, float* MOD, LAS unsigned char* lds, int vcu, int G, int tid) {
    LAS float* sc = (LAS float*)lds;
    LAS float* red = (LAS float*)(lds + 32768);
    const int wave = tid >> 6, lane = tid & 63;
    for (int i = tid; i < NB * DM; i += NTHR) { const float v = c[i]; sc[i] = v / (1.f + expf(-v)); }
    __syncthreads();
    for (int task = vcu; task < 2 * (MODW / 64); task += G) {
        const int l = task / (MODW / 64), cg = task % (MODW / 64), col = cg * 64 + lane;
        const float* W = w_mod + (size_t)l * DM * MODW + col;
        float a0 = 0.f, a1 = 0.f, a2 = 0.f, a3 = 0.f;
        const int k0 = wave * 256;
#pragma unroll 16
        for (int k = 0; k < 256; ++k) {
            const float w = W[(size_t)(k0 + k) * MODW];
            a0 += w * sc[k0 + k]; a1 += w * sc[DM + k0 + k]; a2 += w * sc[2 * DM + k0 + k]; a3 += w * sc[3 * DM + k0 + k];
        }
        red[(wave * 4 + 0) * 64 + lane] = a0; red[(wave * 4 + 1) * 64 + lane] = a1; red[(wave * 4 + 2) * 64 + lane] = a2; red[(wave * 4 + 3) * 64 + lane] = a3;
        __syncthreads();
        if (tid < 256) { const int b = tid >> 6; float s = 0.f;
#pragma unroll
            for (int w = 0; w < 8; ++w) s += red[(w * 4 + b) * 64 + lane];
            MOD[(size_t)(l * NB + b) * MODW + cg * 64 + lane] = s + b_mod[l * MODW + cg * 64 + lane]; }
        __syncthreads();
    }
}
struct TrItem { const float* src; bf16* dst; int ld, K, k0, n0, drow0; };
DI void tr_load(f32x4 (&v)[8], const TrItem& I, int lane) {
    const int rr = lane >> 3, c4 = (lane & 7) * 4;
#pragma unroll
    for (int i = 0; i < 8; ++i) v[i] = *(const f32x4*)(I.src + (size_t)(I.k0 + i * 8 + rr) * I.ld + I.n0 + c4);
}
DI void tr_store(const f32x4 (&v)[8], const TrItem& I, LAS float* scr, int lane) {
    const int rr = lane >> 3, c4 = (lane & 7) * 4;
#pragma unroll
    for (int i = 0; i < 8; ++i) *(LAS f32x4*)(scr + (i * 8 + rr) * 36 + (c4 ^ (4 * i))) = v[i];
    asm volatile("" ::: "memory");
    const int c = lane & 7;
#pragma unroll
    for (int j = 0; j < 4; ++j) { const int n = (lane >> 3) + 8 * j; const LAS float* s = scr + (8 * c) * 36 + (n ^ (4 * c));
        v4u o; o.x = pk2(s[0 * 36], s[1 * 36]); o.y = pk2(s[2 * 36], s[3 * 36]); o.z = pk2(s[4 * 36], s[5 * 36]); o.w = pk2(s[6 * 36], s[7 * 36]);
        *(v4u*)(I.dst + (size_t)(I.drow0 + n) * I.K + I.k0 + 8 * c) = o; }
    asm volatile("" ::: "memory");
}
DI TrItem tr_decode(int it, const float* w_in, const float* w_out, const float* w_gate, const float* w_up, const float* w_down, bf16* WIN, bf16* WOUT, bf16* WGU, bf16* WD) {
    constexpr int I_IN = 32 * 192, I_OUT = 32 * 64, I_G = 32 * 1024, I_D = 32 * 1024;
    constexpr int PER_L = I_IN + I_OUT + 2 * I_G + I_D;
    const int l = it / PER_L; int r = it % PER_L; TrItem I;
    if (r < I_IN) { const int kb = r / 192, nb = r % 192; I.src = w_in + (size_t)l * DM * INW; I.ld = INW; I.k0 = kb * 64; I.n0 = nb * 32; I.dst = WIN + (size_t)l * NPROJ * DM; I.K = DM; I.drow0 = nb * 32; return I; } r -= I_IN;
    if (r < I_OUT) { const int kb = r / 64, nb = r % 64; I.src = w_out + (size_t)l * DM * DM; I.ld = DM; I.k0 = kb * 64; I.n0 = nb * 32; I.dst = WOUT + (size_t)l * DM * DM; I.K = DM; I.drow0 = nb * 32; return I; } r -= I_OUT;
    if (r < 2 * I_G) { const int up = r / I_G; r %= I_G; const int e = r >> 10, kb = (r >> 5) & 31, nb = r & 31, n0 = nb * 32;
        I.src = (up ? w_up : w_gate) + (size_t)(l * NEXP + e) * DM * FFE; I.ld = FFE; I.k0 = kb * 64; I.n0 = n0; I.dst = WGU + (size_t)(l * NEXP + e) * 2048 * DM; I.K = DM; I.drow0 = (n0 >> 7) * 256 + (n0 & 127) + up * 128; return I; } r -= 2 * I_G;
    { const int e = r >> 10, kb = (r >> 6) & 15, nb = r & 63;
        I.src = w_down + (size_t)(l * NEXP + e) * FFE * DM; I.ld = DM; I.k0 = kb * 64; I.n0 = nb * 32; I.dst = WD + (size_t)(l * NEXP + e) * DM * FFE; I.K = FFE; I.drow0 = nb * 32; return I; }
}
DI void p0_convert(const float* w_in, const float* w_out, const float* w_gate, const float* w_up, const float* w_down, const float* rgw, const float* rew, float* WRT, const float* rel_bias, float* BTG,
                   bf16* WIN, bf16* WOUT, bf16* WGU, bf16* WD, LAS unsigned char* lds, int vcu, int G, int tid) {
    const int wave = __builtin_amdgcn_readfirstlane(tid >> 6), lane = tid & 63;
    for (int i = vcu * NTHR + tid; i < 16 * 3 * 176; i += G * NTHR) { const int h = i / 528, q = i % 528, p = q / 176, rel = q % 176 - 32;
        BTG[i] = (rel >= 0 && rel <= 128) ? rel_bias[(int)BUCKET[p][rel] * 16 + h] * 1.4426950408889634f : 0.f; }
    for (int i = vcu * NTHR + tid; i < NLAYER * 36 * DM; i += G * NTHR) { const int l = i / (36 * DM), r = i % (36 * DM), c = r / DM, k = r % DM;
        WRT[(size_t)(l * 48 + c) * DM + k] = (c < 32) ? rew[((size_t)l * DM + k) * 32 + c] : rgw[((size_t)l * DM + k) * 4 + (c - 32)]; }
    LAS float* scr = (LAS float*)(lds + wave * 9216);
    constexpr int NITEMS = NLAYER * (32 * 192 + 32 * 64 + 3 * 32 * 1024);
    const int gw = vcu * NWAVES + wave, NGW = G * NWAVES;
    int it = gw;
    if (it >= NITEMS) return;
    f32x4 va[8], vb[8];
    TrItem Ia = tr_decode(it, w_in, w_out, w_gate, w_up, w_down, WIN, WOUT, WGU, WD), Ib = Ia;
    tr_load(va, Ia, lane);
#pragma unroll 1
    for (;;) {
        const bool hb = (it + NGW < NITEMS);
        if (hb) { Ib = tr_decode(it + NGW, w_in, w_out, w_gate, w_up, w_down, WIN, WOUT, WGU, WD); tr_load(vb, Ib, lane); }
        tr_store(va, Ia, scr, lane);
        if (!hb) break;
        it += NGW;
        const bool ha = (it + NGW < NITEMS);
        if (ha) { Ia = tr_decode(it + NGW, w_in, w_out, w_gate, w_up, w_down, WIN, WOUT, WGU, WD); tr_load(va, Ia, lane); }
        tr_store(vb, Ib, scr, lane);
        if (!ha) break;
        it += NGW;
    }
}

DI void phase_a(int mode, int l, const float* xsrc, float* X, const float* MOD, const float* norm1_w, const float* w_in, const float* gate_b,
                const int* TOKD, const float* TOKW, const bf16* OROWS, bf16* H, float* GATES, LAS unsigned char* lds, int vcu, int G, int tid) {
    const int wave = tid >> 6, lane = tid & 63;
    LAS float* wgT = (LAS float*)lds;
    LAS float* nwp = (LAS float*)(lds + 65536);
    LAS float* shf = (LAS float*)(lds + 73728);
    LAS float* g2t = (LAS float*)(lds + 81920);
    const int RB = T >> (31 - __builtin_clz((unsigned)G)), m_base = vcu * RB, b = m_base >> 12;
    if (mode != 2) {
        const float* wl = w_in + (size_t)l * DM * INW + NPROJ;
        for (int i = tid; i < DM * 2; i += NTHR) { const int k = i >> 1, hf = i & 1; const f32x4 v = *(const f32x4*)(wl + (size_t)k * INW + 4 * hf);
            wgT[(4 * hf + 0) * DM + k] = v.x; wgT[(4 * hf + 1) * DM + k] = v.y; wgT[(4 * hf + 2) * DM + k] = v.z; wgT[(4 * hf + 3) * DM + k] = v.w; }
        const float* sh = MOD + (size_t)(l * NB + b) * MODW; const float* scl = sh + DM; const float* nw = norm1_w + l * DM;
        for (int i = tid; i < DM; i += NTHR) { nwp[i] = nw[i] * (1.f + scl[i]); shf[i] = sh[i]; }
    }
    if (mode != 0) { const float* g2 = MOD + (size_t)((l - 1) * NB + b) * MODW + 5 * DM; for (int i = tid; i < DM; i += NTHR) g2t[i] = g2[i]; }
    __syncthreads();
    int nd0 = 0, nd1 = 0; float nw0 = 0.f, nw1 = 0.f;
    if (mode != 0 && wave < RB) { const int m = m_base + wave; nd0 = TOKD[2 * m]; nd1 = TOKD[2 * m + 1]; nw0 = TOKW[2 * m]; nw1 = TOKW[2 * m + 1]; }
    for (int r = wave; r < RB; r += NWAVES) {
        const int m = m_base + r;
        f32x4 xv[8];
#pragma unroll
        for (int j = 0; j < 8; ++j) xv[j] = *(const f32x4*)(xsrc + (size_t)m * DM + 256 * j + 4 * lane);
        if (mode != 0) {
            const int d0 = nd0, d1 = nd1; const float w0 = nw0, w1 = nw1;
            v2u oa[8], ob[8];
#pragma unroll
            for (int j = 0; j < 8; ++j) { oa[j] = *(const v2u*)(OROWS + (size_t)d0 * DM + 256 * j + 4 * lane); ob[j] = *(const v2u*)(OROWS + (size_t)d1 * DM + 256 * j + 4 * lane); }
            if (r + NWAVES < RB) { const int mn = m + NWAVES; nd0 = TOKD[2 * mn]; nd1 = TOKD[2 * mn + 1]; nw0 = TOKW[2 * mn]; nw1 = TOKW[2 * mn + 1]; }
#pragma unroll
            for (int j = 0; j < 8; ++j) {
                const f32x4 gg = *(const LAS f32x4*)(g2t + 256 * j + 4 * lane);
                xv[j].x += gg.x * (w0 * bflo(oa[j].x) + w1 * bflo(ob[j].x)); xv[j].y += gg.y * (w0 * bfhi(oa[j].x) + w1 * bfhi(ob[j].x));
                xv[j].z += gg.z * (w0 * bflo(oa[j].y) + w1 * bflo(ob[j].y)); xv[j].w += gg.w * (w0 * bfhi(oa[j].y) + w1 * bfhi(ob[j].y));
                *(f32x4*)(X + (size_t)m * DM + 256 * j + 4 * lane) = xv[j];
            }
        }
        if (mode == 2) continue;
        float ss = 0.f;
#pragma unroll
        for (int j = 0; j < 8; ++j) ss += (xv[j].x * xv[j].x + xv[j].y * xv[j].y) + (xv[j].z * xv[j].z + xv[j].w * xv[j].w);
        const float rms = rsqrtf(wave_sum(ss) * (1.f / DM) + EPS);
        float ga[8] = {0.f, 0.f, 0.f, 0.f, 0.f, 0.f, 0.f, 0.f};
#pragma unroll
        for (int j = 0; j < 8; ++j) {
            const int k = 256 * j + 4 * lane;
            const f32x4 w = *(const LAS f32x4*)(nwp + k), s0 = *(const LAS f32x4*)(shf + k);
            f32x4 h; h.x = xv[j].x * rms * w.x + s0.x; h.y = xv[j].y * rms * w.y + s0.y; h.z = xv[j].z * rms * w.z + s0.z; h.w = xv[j].w * rms * w.w + s0.w;
            v2u o; o.x = pk2(h.x, h.y); o.y = pk2(h.z, h.w);
            *(v2u*)(H + (size_t)m * DM + k) = o;
#pragma unroll
            for (int c = 0; c < 8; ++c) { const f32x4 g = *(const LAS f32x4*)(wgT + c * DM + k); ga[c] += (h.x * g.x + h.y * g.y) + (h.z * g.z + h.w * g.w); }
            asm volatile("" ::: "memory");
        }
#pragma unroll
        for (int c = 0; c < 8; ++c) ga[c] = wave_sum(ga[c]);
        if (lane < 8) { float v = ga[0];
#pragma unroll
            for (int c = 1; c < 8; ++c) v = (lane == c) ? ga[c] : v;
            GATES[(size_t)m * 8 + lane] = v + gate_b[l * 8 + lane]; }
    }
}

DI void c0_unpack(const v4u& a, const v4u& bq, float (&v)[16]) {
    v[0] = bflo(a.x); v[1] = bfhi(a.x); v[2] = bflo(a.y); v[3] = bfhi(a.y); v[4] = bflo(a.z); v[5] = bfhi(a.z); v[6] = bflo(a.w); v[7] = bfhi(a.w);
    v[8] = bflo(bq.x); v[9] = bfhi(bq.x); v[10] = bflo(bq.y); v[11] = bfhi(bq.y); v[12] = bflo(bq.z); v[13] = bfhi(bq.z); v[14] = bflo(bq.w); v[15] = bfhi(bq.w);
}
DI void phase_c0(int l, const bf16* PROJ, bf16* QKC, bf16* KH, bf16* QN, const float* q_norm_w, const float* k_norm_w, const float* conv_w, int vcu, int G, int tid) {
    const int wave = tid >> 6, lane = tid & 63;
    const int gw = vcu * NWAVES + wave, NGW = G * NWAVES;
    const int c0 = 16 * lane;
    float cw[4][16], nwq[16], nwk[16];
#pragma unroll
    for (int j = 0; j < 4; ++j)
#pragma unroll
        for (int i = 0; i < 16; i += 4) { const f32x4 w = *(const f32x4*)(conv_w + (size_t)(l * 4 + j) * 1024 + c0 + i); cw[j][i] = w.x; cw[j][i + 1] = w.y; cw[j][i + 2] = w.z; cw[j][i + 3] = w.w; }
#pragma unroll
    for (int i = 0; i < 16; i += 4) { const f32x4 a = *(const f32x4*)(q_norm_w + l * 64 + (lane & 3) * 16 + i), bq = *(const f32x4*)(k_norm_w + l * 64 + (lane & 3) * 16 + i);
        nwq[i] = a.x; nwq[i + 1] = a.y; nwq[i + 2] = a.z; nwq[i + 3] = a.w; nwk[i] = bq.x; nwk[i + 1] = bq.y; nwk[i + 2] = bq.z; nwk[i + 3] = bq.w; }
    const float ksc = (c0 >= 512) ? 0.08838834764831845f : 1.f;
    for (int rg = gw; rg < T / 8; rg += NGW) {
        const int R0 = rg * 8;
        v4u w0a = {0u, 0u, 0u, 0u}, w0b = w0a, w1a = w0a, w1b = w0a, w2a = w0a, w2b = w0a;
        if ((R0 & (SEQ - 1)) != 0) { const bf16* p = PROJ + (size_t)(R0 - 3) * NPROJ + C_MQ + c0;
            w0a = *(const v4u*)p; w0b = *(const v4u*)(p + 8); w1a = *(const v4u*)(p + NPROJ); w1b = *(const v4u*)(p + NPROJ + 8); w2a = *(const v4u*)(p + 2 * NPROJ); w2b = *(const v4u*)(p + 2 * NPROJ + 8); }
        v4u nq0, nq1, nk0, nk1, nc0, nc1;
        { const bf16* p = PROJ + (size_t)R0 * NPROJ + 16 * lane; nq0 = *(const v4u*)p; nq1 = *(const v4u*)(p + 8); nk0 = *(const v4u*)(p + 1024); nk1 = *(const v4u*)(p + 1032);
          const bf16* pc = PROJ + (size_t)R0 * NPROJ + C_MQ + c0; nc0 = *(const v4u*)pc; nc1 = *(const v4u*)(pc + 8); }
#pragma unroll 1
        for (int i = 0; i < 8; ++i) {
            const int m = R0 + i;
            const v4u q0 = nq0, q1 = nq1, k0 = nk0, k1 = nk1, w3a = nc0, w3b = nc1;
            if (i < 7) { const bf16* p = PROJ + (size_t)(m + 1) * NPROJ + 16 * lane; nq0 = *(const v4u*)p; nq1 = *(const v4u*)(p + 8); nk0 = *(const v4u*)(p + 1024); nk1 = *(const v4u*)(p + 1032);
                const bf16* pc = PROJ + (size_t)(m + 1) * NPROJ + C_MQ + c0; nc0 = *(const v4u*)pc; nc1 = *(const v4u*)(pc + 8); }
            float v[16];
            {
                c0_unpack(q0, q1, v); float ss = 0.f;
#pragma unroll
                for (int e = 0; e < 16; ++e) ss += v[e] * v[e];
                ss += __shfl_xor(ss, 1); ss += __shfl_xor(ss, 2);
                const float r = rsqrtf(ss * (1.f / 64.f) + EPS) * (0.125f * 1.4426950408889634f);
#pragma unroll
                for (int e = 0; e < 16; ++e) v[e] = v[e] * r * nwq[e];
                v4u o0, o1; o0.x = pk2(v[0], v[1]); o0.y = pk2(v[2], v[3]); o0.z = pk2(v[4], v[5]); o0.w = pk2(v[6], v[7]); o1.x = pk2(v[8], v[9]); o1.y = pk2(v[10], v[11]); o1.z = pk2(v[12], v[13]); o1.w = pk2(v[14], v[15]);
                bf16* dstp = QN + (size_t)m * 1024 + 16 * lane; *(v4u*)dstp = o0; *(v4u*)(dstp + 8) = o1;
            }
            {
                c0_unpack(k0, k1, v); float ss = 0.f;
#pragma unroll
                for (int e = 0; e < 16; ++e) ss += v[e] * v[e];
                ss += __shfl_xor(ss, 1); ss += __shfl_xor(ss, 2);
                const float r = rsqrtf(ss * (1.f / 64.f) + EPS);
#pragma unroll
                for (int e = 0; e < 16; ++e) v[e] = v[e] * r * nwk[e];
                v4u o0, o1; o0.x = pk2(v[0], v[1]); o0.y = pk2(v[2], v[3]); o0.z = pk2(v[4], v[5]); o0.w = pk2(v[6], v[7]); o1.x = pk2(v[8], v[9]); o1.y = pk2(v[10], v[11]); o1.z = pk2(v[12], v[13]); o1.w = pk2(v[14], v[15]);
                bf16* dstp = KH + ((size_t)((m >> 12) * 16 + (lane >> 2)) * SEQ + (m & (SEQ - 1))) * 64 + (lane & 3) * 16; *(v4u*)dstp = o0; *(v4u*)(dstp + 8) = o1;
            }
            {
                float y[16], x[16];
                c0_unpack(w0a, w0b, x);
#pragma unroll
                for (int e = 0; e < 16; ++e) y[e] = cw[0][e] * x[e];
                c0_unpack(w1a, w1b, x);
#pragma unroll
                for (int e = 0; e < 16; ++e) y[e] += cw[1][e] * x[e];
                c0_unpack(w2a, w2b, x);
#pragma unroll
                for (int e = 0; e < 16; ++e) y[e] += cw[2][e] * x[e];
                c0_unpack(w3a, w3b, x);
#pragma unroll
                for (int e = 0; e < 16; ++e) y[e] = siluf_(y[e] + cw[3][e] * x[e]) * ksc;
                v4u o0, o1; o0.x = pk2(y[0], y[1]); o0.y = pk2(y[2], y[3]); o0.z = pk2(y[4], y[5]); o0.w = pk2(y[6], y[7]); o1.x = pk2(y[8], y[9]); o1.y = pk2(y[10], y[11]); o1.z = pk2(y[12], y[13]); o1.w = pk2(y[14], y[15]);
                bf16* qd = QKC + (size_t)m * 1024 + c0; *(v4u*)qd = o0; *(v4u*)(qd + 8) = o1;
                w0a = w1a; w0b = w1b; w1a = w2a; w1b = w2b; w2a = w3a; w2b = w3b;
            }
        }
    }
}

DI void phase_d(const float* CG, const float* CM, float* MS, const float* __restrict__ CL, bf16* __restrict__ CS, const float* NLOC, float* NS, LAS unsigned char* lds, int vcu, int G, int tid) {
    LAS float* dec = (LAS float*)lds;
    LAS float* inj = dec + 512;
    dec[tid] = CG[tid]; inj[tid] = CM[tid];
    __syncthreads();
    if (tid < 16) { float m = 0.f;
#pragma unroll 1
        for (int c = 0; c < 32; ++c) { const int u = tid * 32 + c; const float gg = dec[u], ml = inj[u]; const float mn = fmaxf(gg + m, ml);
            dec[u] = expf(gg + m - mn); inj[u] = expf(ml - mn); if (vcu == 0) MS[u] = m; m = mn; } }
    __syncthreads();
    for (int v = vcu * NTHR + tid; v < 16 * 8192; v += G * NTHR) {
        const int bh = v >> 13, i4 = (v & 8191) * 4;
        f32x4 C = {0.f, 0.f, 0.f, 0.f};
#pragma unroll 1
        for (int c0 = 0; c0 < 32; c0 += 8) {
            f32x4 cl[8];
#pragma unroll
            for (int c = 0; c < 8; ++c) cl[c] = *(const f32x4*)(CL + (size_t)(bh * 32 + c0 + c) * 32768 + i4);
#pragma unroll
            for (int c = 0; c < 8; ++c) { const int u = bh * 32 + c0 + c; v2u o; o.x = pk2(C.x, C.y); o.y = pk2(C.z, C.w);
                *(v2u*)(CS + (size_t)u * 32768 + i4) = o; const float d = dec[u], ij = inj[u]; C = C * d + cl[c] * ij; }
        }
    }
    if (vcu == (G > 1 ? 1 : 0)) {
        for (int e = tid; e < 16 * 128; e += NTHR) { const int bh = e >> 7, dk = e & 127; float n = 0.f;
#pragma unroll 4
            for (int c = 0; c < 32; ++c) { const int u = bh * 32 + c; NS[u * 128 + dk] = n; n = dec[u] * n + inj[u] * NLOC[u * 128 + dk]; } }
    }
}

typedef float f32x4m __attribute__((ext_vector_type(4)));
DI void phase_g(int l, const float* X, const float* MOD, const float* norm2_w, const float* wg, const float* bg, const float* we, const float* be, const float* WRT,
                bf16* H, int* TOKE, float* TOKW, int* TOKR, int* HIST, LAS unsigned char* lds, int vcu, int G, int tid) {
    const int wave = __builtin_amdgcn_readfirstlane(tid >> 6), lane = tid & 63;
    LAS float* nwp = (LAS float*)lds;
    LAS float* shf = (LAS float*)(lds + 8192);
    LAS float* part = (LAS float*)(lds + 16384);
    LAS float* ssqp = (LAS float*)(lds + 40960);
    LAS float* biasp = (LAS float*)(lds + 43008);
    LAS float* rmsv = (LAS float*)(lds + 43264);
    LAS float* red = (LAS float*)(lds + 43520);
    LAS int* esel = (LAS int*)(lds + 44800);
    for (int round = vcu; round < T / 64; round += G) {
        const int m0 = round * 64, b = m0 >> 12;
        const float* sh2 = MOD + (size_t)(l * NB + b) * MODW + 3 * DM; const float* sc2 = sh2 + DM;
        for (int i = tid; i < DM; i += NTHR) { nwp[i] = norm2_w[l * DM + i] * (1.f + sc2[i]); shf[i] = sh2[i]; }
        __syncthreads();
        {
            float pb[36];
#pragma unroll
            for (int c = 0; c < 36; ++c) pb[c] = 0.f;
#pragma unroll
            for (int i = 0; i < 4; ++i) { const int k = tid + NTHR * i; const float s = shf[k];
#pragma unroll
                for (int q = 0; q < 8; ++q) { const f32x4 w = *(const f32x4*)(we + (size_t)k * 32 + 4 * q); pb[4 * q] += s * w.x; pb[4 * q + 1] += s * w.y; pb[4 * q + 2] += s * w.z; pb[4 * q + 3] += s * w.w; }
                const f32x4 w = *(const f32x4*)(wg + (size_t)k * 4); pb[32] += s * w.x; pb[33] += s * w.y; pb[34] += s * w.z; pb[35] += s * w.w; }
#pragma unroll
            for (int c = 0; c < 36; ++c) { const float v = wave_sum(pb[c]); if (lane == 0) red[wave * 36 + c] = v; }
            __syncthreads();
            if (tid < 36) { float s = 0.f;
#pragma unroll
                for (int w = 0; w < 8; ++w) s += red[w * 36 + tid];
                biasp[tid] = s + (tid < 32 ? be[tid] : bg[tid - 32]); }
        }
        {
            const int rt = wave & 3, kh = wave >> 2, row = lane & 15, kq = lane >> 4, col = lane & 15;
            const float* xr = X + (size_t)(m0 + 16 * rt + row) * DM + kh * 1024 + 4 * kq;
            const float* w0p = WRT + (size_t)(l * 48 + col) * DM + kh * 1024 + 4 * kq;
            const float* w1p = w0p + (size_t)16 * DM; const float* w2p = WRT + (size_t)(l * 48 + 32 + (col & 3)) * DM + kh * 1024 + 4 * kq;
            const LAS float* nwq = nwp + kh * 1024 + 4 * kq;
            f32x4 a0 = {0.f, 0.f, 0.f, 0.f}, a1 = a0, a2 = a0; float ssq = 0.f;
#pragma unroll 8
            for (int jj = 0; jj < 64; ++jj) {
                const f32x4 xv = *(const f32x4*)(xr + 16 * jj);
                const f32x4 nw = *(const LAS f32x4*)(nwq + 16 * jj);
                f32x4 b0 = *(const f32x4*)(w0p + 16 * jj), b1 = *(const f32x4*)(w1p + 16 * jj), b2 = *(const f32x4*)(w2p + 16 * jj);
                if (col >= 4) b2 = (f32x4){0.f, 0.f, 0.f, 0.f};
                ssq += (xv.x * xv.x + xv.y * xv.y) + (xv.z * xv.z + xv.w * xv.w);
                b0 = b0 * nw; b1 = b1 * nw; b2 = b2 * nw;
#pragma unroll
                for (int e = 0; e < 4; ++e) {
                    a0 = __builtin_amdgcn_mfma_f32_16x16x4f32(xv[e], b0[e], a0, 0, 0, 0);
                    a1 = __builtin_amdgcn_mfma_f32_16x16x4f32(xv[e], b1[e], a1, 0, 0, 0);
                    a2 = __builtin_amdgcn_mfma_f32_16x16x4f32(xv[e], b2[e], a2, 0, 0, 0); }
            }
#pragma unroll
            for (int r = 0; r < 4; ++r) { LAS float* p = part + ((kh * 64 + 16 * rt + 4 * kq + r) * 48); p[col] = a0[r]; p[16 + col] = a1[r]; p[32 + col] = a2[r]; }
            ssqp[(kh * 64 + 16 * rt + row) * 4 + kq] = ssq;
        }
        __syncthreads();
        if (tid < 64) { float ss = 0.f;
#pragma unroll
            for (int i = 0; i < 4; ++i) ss += ssqp[tid * 4 + i] + ssqp[(64 + tid) * 4 + i];
            rmsv[tid] = rsqrtf(ss * (1.f / DM) + EPS); }
        __syncthreads();
        if (wave == 0) {
            const int r = lane, m = m0 + r;
            const float rms = rmsv[r];
            const LAS float* p0 = part + r * 48; const LAS float* p1 = part + (64 + r) * 48;
            float lg[4];
#pragma unroll
            for (int j = 0; j < 4; ++j) lg[j] = rms * (p0[32 + j] + p1[32 + j]) + biasp[32 + j];
            int gs = 0; float gm = lg[0];
#pragma unroll
            for (int j = 1; j < 4; ++j) if (lg[j] > gm) { gm = lg[j]; gs = j; }
            float den = 0.f;
#pragma unroll
            for (int j = 0; j < 4; ++j) den += expf(lg[j] - gm);
            const float pg = 1.f / den;
            float v0 = -3.0e38f, v1 = -3.0e38f; int i0 = 0, i1 = 0;
#pragma unroll 1
            for (int i = 0; i < 8; ++i) { const int c = gs * 8 + i; const float v = rms * (p0[c] + p1[c]) + biasp[c];
                if (v > v0) { v1 = v0; i1 = i0; v0 = v; i0 = i; } else if (v > v1) { v1 = v; i1 = i; } }
            const float t = expf(v1 - v0), w0 = pg / (1.f + t), w1 = pg * t / (1.f + t);
            const int e0 = gs * 8 + i0, e1 = gs * 8 + i1;
            esel[2 * r] = e0; esel[2 * r + 1] = e1;
            TOKE[2 * m] = e0; TOKE[2 * m + 1] = e1; TOKW[2 * m] = w0; TOKW[2 * m + 1] = w1;
            LDS_WAIT(); asm volatile("" ::: "memory");
            int r0 = 0, r1 = 0;
#pragma unroll 2
            for (int q = 0; q < r; ++q) { const int a = esel[2 * q], c = esel[2 * q + 1]; r0 += (a == e0) + (c == e0); r1 += (a == e1) + (c == e1); }
            TOKR[2 * m] = r0; TOKR[2 * m + 1] = r1;
            if (lane < 32) { int n = 0;
#pragma unroll 8
                for (int q = 0; q < 128; ++q) n += (esel[q] == lane);
                HIST[round * 32 + lane] = n; }
        } else {
#pragma unroll 1
            for (int r = wave - 1; r < 64; r += 14) { const int r2 = (r + 7 < 64) ? r + 7 : r; const int m = m0 + r, m2 = m0 + r2; const float rms0 = rmsv[r], rms1 = rmsv[r2];
                f32x4 xa[8], xb[8];
#pragma unroll
                for (int j = 0; j < 8; ++j) { xa[j] = *(const f32x4*)(X + (size_t)m * DM + 256 * j + 4 * lane); xb[j] = *(const f32x4*)(X + (size_t)m2 * DM + 256 * j + 4 * lane); }
#pragma unroll
                for (int j = 0; j < 8; ++j) { const int k = 256 * j + 4 * lane;
                    const f32x4 nw = *(const LAS f32x4*)(nwp + k), s0 = *(const LAS f32x4*)(shf + k);
                    v2u o; o.x = pk2(xa[j].x * rms0 * nw.x + s0.x, xa[j].y * rms0 * nw.y + s0.y); o.y = pk2(xa[j].z * rms0 * nw.z + s0.z, xa[j].w * rms0 * nw.w + s0.w);
                    *(v2u*)(H + (size_t)m * DM + k) = o;
                    o.x = pk2(xb[j].x * rms1 * nw.x + s0.x, xb[j].y * rms1 * nw.y + s0.y); o.y = pk2(xb[j].z * rms1 * nw.z + s0.z, xb[j].w * rms1 * nw.w + s0.w);
                    *(v2u*)(H + (size_t)m2 * DM + k) = o; } }
        }
        __syncthreads();
    }
}

DI void phase_h0(const int* HIST, const int* TOKE, const int* TOKR, int* TOKD, int* ROWTOK, int* TILE, LAS unsigned char* lds, int vcu, int G, int tid) {
    LAS int* pre = (LAS int*)lds;
    LAS int* cnt = pre + 8192;
    LAS int* rowstart = cnt + 32;
    for (int i = tid; i < 8192; i += NTHR) pre[i] = HIST[i];
    __syncthreads();
    {
        LAS int* seg = rowstart + 32;
        const int e = tid & 31, sg = tid >> 5; int run = 0;
#pragma unroll
        for (int r = 0; r < 16; ++r) { const int idx = (sg * 16 + r) * 32 + e; const int t = pre[idx]; pre[idx] = run; run += t; }
        seg[sg * 32 + e] = run;
        __syncthreads();
        if (tid < 32) { int acc = 0;
#pragma unroll
            for (int s = 0; s < 16; ++s) { const int t = seg[s * 32 + tid]; seg[s * 32 + tid] = acc; acc += t; }
            cnt[tid] = acc; }
        __syncthreads();
        const int off = seg[sg * 32 + e];
#pragma unroll
        for (int r = 0; r < 16; ++r) pre[(sg * 16 + r) * 32 + e] += off;
    }
    __syncthreads();
    if (tid == 0) { int ts = 0;
#pragma unroll 1
        for (int e = 0; e < 32; ++e) { rowstart[e] = ts * 256; const int nt = (cnt[e] + 255) >> 8;
            if (vcu == 0) {
#pragma unroll 1
                for (int i = 0; i < nt; ++i) TILE[1 + ts + i] = e; }
            ts += nt; }
        if (vcu == 0) TILE[0] = ts; }
    __syncthreads();
    if (vcu < 32) {
        const int e = vcu, nt = (cnt[e] + 255) >> 8;
        for (int i = cnt[e] + tid; i < nt * 256; i += NTHR) ROWTOK[rowstart[e] + i] = 0;
    }
    for (int m = vcu * NTHR + tid; m < T; m += G * NTHR) {
        const int e0 = TOKE[2 * m], e1 = TOKE[2 * m + 1], round = m >> 6;
        const int d0 = rowstart[e0] + pre[round * 32 + e0] + TOKR[2 * m], d1 = rowstart[e1] + pre[round * 32 + e1] + TOKR[2 * m + 1];
        TOKD[2 * m] = d0; TOKD[2 * m + 1] = d1; ROWTOK[d0] = m; ROWTOK[d1] = m;
    }
}

constexpr int AT_OACC = 0, AT_ML = 69632, AT_BT = 71680, AT_VB = 73984, AT_VBW = 4608, AT_BTS = 176;
constexpr float LOG2E = 1.4426950408889634f;
DI void at_softmax(f32x4 (&s)[9], int p, int qs0, int li, int g, const LAS float* BT, float& mx, float& lsum) {
    int lbr = li - 4 * g + 128; asm volatile("" : "+v"(lbr));
    const int kb0 = qs0 - 128 + 4 * g;
    const LAS float* btp = BT + p * AT_BTS + (lbr - 116);
    mx = -1.0e30f;
    if (qs0 >= 128) {
#pragma unroll
        for (int kt = 0; kt < 9; ++kt)
#pragma unroll
            for (int e = 0; e < 4; ++e) { const int c = 16 * kt + e, rel = lbr - c;
                float v = s[kt][e] + btp[148 - c];
                if (kt == 0) v = (rel <= 128) ? v : -1.0e30f;
                if (kt == 8) v = (rel >= 0) ? v : -1.0e30f;
                s[kt][e] = v; mx = fmaxf(mx, v); }
    } else {
#pragma unroll
        for (int kt = 0; kt < 9; ++kt)
#pragma unroll
            for (int e = 0; e < 4; ++e) { const int c = 16 * kt + e, rel = lbr - c;
                const bool valid = (rel >= 0) && (rel <= 128) && (kb0 + c >= 0);
                const float v = valid ? s[kt][e] + btp[148 - c] : -1.0e30f;
                s[kt][e] = v; mx = fmaxf(mx, v); }
    }
    mx = fmaxf(mx, __shfl_xor(mx, 16)); mx = fmaxf(mx, __shfl_xor(mx, 32));
    lsum = 0.f;
#pragma unroll
    for (int kt = 0; kt < 9; ++kt)
#pragma unroll
        for (int e = 0; e < 4; ++e) { const float pv = __builtin_amdgcn_exp2f(s[kt][e] - mx); s[kt][e] = pv; lsum += pv; }
    lsum += __shfl_xor(lsum, 16); lsum += __shfl_xor(lsum, 32);
}
DI bf16x8 at_pack(const f32x4& a, const f32x4& b) { v4u w; w.x = pk2(a[0], a[1]); w.y = pk2(a[2], a[3]); w.z = pk2(b[0], b[1]); w.w = pk2(b[2], b[3]); return __builtin_bit_cast(bf16x8, w); }
DI void at_merge(const f32x4 (&acc)[4], float mx, float lsum, int tau, int g, bool first, LAS float* OACC, LAS float* MLs) {
    LAS float* orow = OACC + tau * 68 + 4 * g;
    if (first) {
#pragma unroll
        for (int dt = 0; dt < 4; ++dt) *(LAS f32x4*)(orow + 16 * dt) = acc[dt];
        if (g == 0) { MLs[2 * tau] = mx; MLs[2 * tau + 1] = lsum; }
    } else {
        const float M0 = MLs[2 * tau], L0 = MLs[2 * tau + 1];
        const float Mn = fmaxf(M0, mx), c0 = __builtin_amdgcn_exp2f(M0 - Mn), c1 = __builtin_amdgcn_exp2f(mx - Mn);
#pragma unroll
        for (int dt = 0; dt < 4; ++dt) { const f32x4 o = *(const LAS f32x4*)(orow + 16 * dt); *(LAS f32x4*)(orow + 16 * dt) = o * c0 + acc[dt] * c1; }
        LDS_WAIT();
        if (g == 0) { MLs[2 * tau] = Mn; MLs[2 * tau + 1] = L0 * c0 + lsum * c1; }
    }
}
template <int MODE> DI void attn_unit(int b, int h, int tt, const bf16* QN, const bf16* KH, const bf16* VH, bf16* MIXED, const float* rel_bias, LAS unsigned char* lds, int tid) {
    const int wave = __builtin_amdgcn_readfirstlane(tid >> 6), lane = tid & 63, g = lane >> 4, li = lane & 15;
    LAS float* OACC = (LAS float*)(lds + AT_OACC);
    LAS float* MLs = (LAS float*)(lds + AT_ML);
    LAS float* BT = (LAS float*)(lds + AT_BT);
    LAS bf16* VB = (LAS bf16*)(lds + AT_VB + wave * AT_VBW);
    for (int i = tid; i < 3 * AT_BTS; i += NTHR) BT[i] = rel_bias[h * (3 * AT_BTS) + i];
    __syncthreads();
    const size_t rowbase = (size_t)b * SEQ;
    const int t0 = tt * 256;
    const char* qbase = (const char*)(QN + rowbase * 1024 + h * 64);
    const char* kbase = (const char*)(KH + (size_t)(b * 16 + h) * SEQ * 64); const char* vbase = (const char*)(VH + (size_t)(b * 16 + h) * SEQ * 64);
    LAS bf16* wdst = VB + (lane >> 3) * 72 + (lane & 7) * 8;
    const LAS bf16* kfrag = VB + li * 72 + 8 * g;
    const LAS bf16* vfrag = VB + (4 * g + (li >> 2)) * 72 + 4 * (li & 3);
#ifndef AT_PAIR
#define AT_PAIR 0
#endif
#if AT_PAIR
#pragma unroll 1
    for (int p = 0; p < 2; ++p) {
        if (!((AT_PAIR >> p) & 1)) continue;
        const int sh = 2 * p, j = 2 * wave;
        const int r = (p == 0) ? 0 : (j >> 2), sb = (p == 0) ? j : (j & 3);
        const int qs0 = (t0 >> sh) + 16 * sb;
        const int tqa = ((qs0 + li) << sh) + r, tqb = ((qs0 + 16 + li) << sh) + r;
        bf16x8 qa0, qa1, qb0, qb1; v4u kr[20], vr[20];
        {   const unsigned qo = (unsigned)(tqa * 1024 + 8 * g) * 2u, qo2 = (unsigned)(tqb * 1024 + 8 * g) * 2u;
            qa0 = *(const bf16x8*)(qbase + qo); qa1 = *(const bf16x8*)(qbase + qo + 64); qb0 = *(const bf16x8*)(qbase + qo2); qb1 = *(const bf16x8*)(qbase + qo2 + 64);
#pragma unroll
            for (int i = 0; i < 20; ++i) { const int ks = min(max(qs0 - 128 + 8 * i + (lane >> 3), 0), qs0 + 31); const unsigned o = (unsigned)(((ks << sh) + r) * 64 + (lane & 7) * 8) * 2u;
                kr[i] = *(const v4u*)(kbase + o); vr[i] = *(const v4u*)(vbase + o); } }
        f32x4 sa[9], sb_[9];
#pragma unroll
        for (int c = 0; c < 5; ++c) {
#pragma unroll
            for (int i = 0; i < 4; ++i) *(LAS v4u*)(wdst + 8 * i * 72) = kr[4 * c + i];
            asm volatile("" ::: "memory");
#pragma unroll
            for (int t2 = 0; t2 < 2; ++t2) { const int t = 2 * c + t2; const bf16x8 k0 = *(const LAS bf16x8*)(kfrag + 16 * t2 * 72), k1 = *(const LAS bf16x8*)(kfrag + 16 * t2 * 72 + 32);
                if (t < 9) { f32x4 z = {0.f, 0.f, 0.f, 0.f}; z = MFMA16(k0, qa0, z); sa[t] = MFMA16(k1, qa1, z); }
                if (t >= 1) { f32x4 z = {0.f, 0.f, 0.f, 0.f}; z = MFMA16(k0, qb0, z); sb_[t - 1] = MFMA16(k1, qb1, z); } }
            asm volatile("" ::: "memory");
        }
        float mxa, lsa, mxb, lsb;
        at_softmax(sa, p, qs0, li, g, BT, mxa, lsa);
        at_softmax(sb_, p, qs0 + 16, li, g, BT, mxb, lsb);
        f32x4 acca[4], accb[4];
#pragma unroll
        for (int dt = 0; dt < 4; ++dt) { acca[dt] = (f32x4){0.f, 0.f, 0.f, 0.f}; accb[dt] = acca[dt]; }
        const f32x4 zero4 = {0.f, 0.f, 0.f, 0.f};
#pragma unroll
        for (int s2 = 0; s2 < 5; ++s2) {
#pragma unroll
            for (int i = 0; i < 4; ++i) *(LAS v4u*)(wdst + 8 * i * 72) = vr[4 * s2 + i];
            asm volatile("" ::: "memory");
            const bf16x8 pa = at_pack(sa[2 * s2], (s2 < 4) ? sa[2 * s2 + 1] : zero4);
            const bf16x8 pb = at_pack((s2 > 0) ? sb_[2 * s2 - 1] : zero4, sb_[2 * s2]);
#pragma unroll
            for (int dt = 0; dt < 4; ++dt) { const bf16x8 vf = mk8(tr_read(vfrag + 16 * dt), tr_read(vfrag + 16 * dt + 16 * 72));
                acca[dt] = MFMA16(vf, pa, acca[dt]); accb[dt] = MFMA16(vf, pb, accb[dt]); }
            asm volatile("" ::: "memory");
        }
        at_merge(acca, mxa, lsa, tqa - t0, g, p == 0, OACC, MLs);
        at_merge(accb, mxb, lsb, tqb - t0, g, p == 0, OACC, MLs);
        __syncthreads();
    }
#endif
#pragma unroll 1
    for (int gi = 0; gi < 6; ++gi) {
        if (gi < 4 && ((AT_PAIR >> (gi >> 1)) & 1)) continue;
        const int p = gi >> 1, jj = gi & 1, sh = 2 * p, j = 2 * wave + jj;
        const int r = (p == 0) ? 0 : (p == 1 ? (j >> 2) : j), sbx = (p == 0) ? j : (p == 1 ? (j & 3) : 0), qs0 = (t0 >> sh) + 16 * sbx;
        const int tq = ((qs0 + li) << sh) + r;
        bf16x8 qf0, qf1; v4u kr[18], vr[20];
        {   const unsigned qo = (unsigned)(tq * 1024 + 8 * g) * 2u; qf0 = *(const bf16x8*)(qbase + qo); qf1 = *(const bf16x8*)(qbase + qo + 64);
#pragma unroll
            for (int i = 0; i < 20; ++i) { const int ks = min(max(qs0 - 128 + 8 * i + (lane >> 3), 0), qs0 + 15); const unsigned o = (unsigned)(((ks << sh) + r) * 64 + (lane & 7) * 8) * 2u;
                if (i < 18) kr[i] = *(const v4u*)(kbase + o);
                vr[i] = *(const v4u*)(vbase + o); } }
        f32x4 s[9];
#pragma unroll
        for (int c = 0; c < 5; ++c) {
#pragma unroll
            for (int i = 0; i < 4; ++i) if (4 * c + i < 18) *(LAS v4u*)(wdst + 8 * i * 72) = kr[4 * c + i];
            asm volatile("" ::: "memory");
#pragma unroll
            for (int t2 = 0; t2 < 2; ++t2) { const int t = 2 * c + t2; if (t < 9) { f32x4 z = {0.f, 0.f, 0.f, 0.f};
                z = MFMA16(*(const LAS bf16x8*)(kfrag + 16 * t2 * 72), qf0, z); s[t] = MFMA16(*(const LAS bf16x8*)(kfrag + 16 * t2 * 72 + 32), qf1, z); } }
            asm volatile("" ::: "memory");
        }
        float mx, lsum;
        at_softmax(s, p, qs0, li, g, BT, mx, lsum);
        f32x4 acc[4];
#pragma unroll
        for (int dt = 0; dt < 4; ++dt) acc[dt] = (f32x4){0.f, 0.f, 0.f, 0.f};
        const f32x4 zero4 = {0.f, 0.f, 0.f, 0.f};
#pragma unroll
        for (int s2 = 0; s2 < 5; ++s2) {
#pragma unroll
            for (int i = 0; i < 4; ++i) *(LAS v4u*)(wdst + 8 * i * 72) = vr[4 * s2 + i];
            asm volatile("" ::: "memory");
            const bf16x8 pf = at_pack(s[2 * s2], (s2 < 4) ? s[2 * s2 + 1] : zero4);
#pragma unroll
            for (int dt = 0; dt < 4; ++dt) acc[dt] = MFMA16(mk8(tr_read(vfrag + 16 * dt), tr_read(vfrag + 16 * dt + 16 * 72)), pf, acc[dt]);
            asm volatile("" ::: "memory");
        }
        at_merge(acc, mx, lsum, tq - t0, g, p == 0, OACC, MLs);
        if (jj == 1) __syncthreads();
    }
    __syncthreads();
    {
        const int tau = tid >> 1, hf = tid & 1;
        const float inv = 1.f / MLs[2 * tau + 1];
        const LAS float* o = OACC + tau * 68 + hf * 32;
        bf16* dst = MIXED + (rowbase + t0 + tau) * DM + h * 64 + hf * 32;
#pragma unroll
        for (int i = 0; i < 4; ++i) { const f32x4 a = *(const LAS f32x4*)(o + 8 * i), c = *(const LAS f32x4*)(o + 8 * i + 4);
            v4u w; w.x = pk2(a.x * inv, a.y * inv); w.y = pk2(a.z * inv, a.w * inv); w.z = pk2(c.x * inv, c.y * inv); w.w = pk2(c.z * inv, c.w * inv);
            *(v4u*)(dst + 8 * i) = w; }
    }
    __syncthreads();
}

constexpr int ML_SC = 0, ML_KW = 4096, ML_VS = 4096 + 128 * 136 * 2;
DI void mlstm_local_unit(int u, const bf16* PROJ, const bf16* QKC, const float* GATES, float* BCUM, float* CG, float* CM, float* CL, float* NLOC, LAS unsigned char* lds, int tid) {
    const int wave = __builtin_amdgcn_readfirstlane(tid >> 6), lane = tid & 63, g = lane >> 4, li = lane & 15;
    const int b = u >> 7, hh = (u >> 5) & 3, c = u & 31, m0 = b * SEQ + c * 128;
    LAS float* sc = (LAS float*)(lds + ML_SC);
    LAS bf16* Kw = (LAS bf16*)(lds + ML_KW);
    LAS bf16* Vs = (LAS bf16*)(lds + ML_VS);
    v4u rk[4], rv[8];
#pragma unroll
    for (int i = 0; i < 4; ++i) { const int id = tid + NTHR * i; rk[i] = *(const v4u*)(QKC + (size_t)(m0 + (id >> 4)) * 1024 + 512 + hh * 128 + (id & 15) * 8); }
#pragma unroll
    for (int i = 0; i < 8; ++i) { const int id = tid + NTHR * i; rv[i] = *(const v4u*)(PROJ + (size_t)(m0 + (id >> 5)) * NPROJ + C_MV + hh * 256 + (id & 31) * 8); }
    float ip = 0.f, bc = 0.f;
    if (tid < 128) {
        ip = GATES[(size_t)(m0 + tid) * 8 + hh]; const float fp = GATES[(size_t)(m0 + tid) * 8 + 4 + hh];
        float v = logsigmoidf_(fp);
#pragma unroll
        for (int o = 1; o < 64; o <<= 1) { const float t = __shfl_up(v, o); if (lane >= o) v += t; }
        bc = v;
        if (tid == 63) sc[384] = v;
    }
    __syncthreads();
    if (tid < 128) { if (tid >= 64) bc += sc[384]; sc[tid] = bc; BCUM[(size_t)(m0 + tid) * 4 + hh] = bc; }
    __syncthreads();
    if (tid < 128) { const float gs = sc[127]; const float a = gs - bc + ip; sc[128 + tid] = a; const float wm = wave_max(a); if (lane == 0) sc[385 + wave] = wm; }
    __syncthreads();
    const float mloc = fmaxf(sc[385], sc[386]);
    if (tid < 128) sc[256 + tid] = expf(sc[128 + tid] - mloc);
    if (tid == 0) { CG[u] = sc[127]; CM[u] = mloc; }
    __syncthreads();
#pragma unroll
    for (int i = 0; i < 4; ++i) { const int id = tid + NTHR * i, row = id >> 4, ch = id & 15; const float w = sc[256 + row]; const v4u a = rk[i];
        v4u o; o.x = pk2(bflo(a.x) * w, bfhi(a.x) * w); o.y = pk2(bflo(a.y) * w, bfhi(a.y) * w); o.z = pk2(bflo(a.z) * w, bfhi(a.z) * w); o.w = pk2(bflo(a.w) * w, bfhi(a.w) * w);
        *(LAS v4u*)(Kw + row * 136 + ch * 8) = o; }
#pragma unroll
    for (int i = 0; i < 8; ++i) { const int id = tid + NTHR * i, row = id >> 5, ch = id & 31; *(LAS v4u*)(Vs + row * 264 + ch * 8) = rv[i]; }
    __syncthreads();
    f32x4 acc[2][8];
#pragma unroll
    for (int vi = 0; vi < 2; ++vi)
#pragma unroll
        for (int kt = 0; kt < 8; ++kt) acc[vi][kt] = (f32x4){0.f, 0.f, 0.f, 0.f};
#pragma unroll
    for (int s4 = 0; s4 < 4; ++s4) {
        const int rbase = 32 * s4 + 8 * g + (li >> 2), cofs = 4 * (li & 3);
        bf16x8 af[2];
#pragma unroll
        for (int vi = 0; vi < 2; ++vi) { const LAS bf16* p = Vs + rbase * 264 + 16 * (2 * wave + vi) + cofs; af[vi] = mk8(tr_read(p), tr_read(p + 4 * 264)); }
#pragma unroll
        for (int kt = 0; kt < 8; ++kt) { const LAS bf16* p = Kw + rbase * 136 + 16 * kt + cofs; const bf16x8 bfr = mk8(tr_read(p), tr_read(p + 4 * 136));
            acc[0][kt] = MFMA16(af[0], bfr, acc[0][kt]); acc[1][kt] = MFMA16(af[1], bfr, acc[1][kt]); }
    }
    float* out = CL + (size_t)u * 32768;
#pragma unroll
    for (int vi = 0; vi < 2; ++vi)
#pragma unroll
        for (int kt = 0; kt < 8; ++kt)
#pragma unroll
            for (int e = 0; e < 4; ++e) out[(size_t)(16 * (2 * wave + vi) + 4 * g + e) * 128 + 16 * kt + li] = acc[vi][kt][e];
    {
        const int dk = tid & 127, part = tid >> 7; float n = 0.f;
#pragma unroll 8
        for (int s = 0; s < 32; ++s) n += bf2f((unsigned)Kw[(32 * part + s) * 136 + dk]);
        sc[512 + tid] = n;
        __syncthreads();
        if (tid < 128) NLOC[(size_t)u * 128 + tid] = (sc[512 + tid] + sc[640 + tid]) + (sc[768 + tid] + sc[896 + tid]);
    }
    __syncthreads();
}

constexpr int MO_VS = 0, MO_SC = 128 * 264 * 2, MO_CS = MO_SC + 4096;
static_assert(MO_CS + 256 * 136 * 2 <= LDS_PERSIST, "mLSTM-out LDS map");
DI void mlstm_out_unit(int l, int u, const bf16* PROJ, const bf16* QKC, const float* GATES, const float* BCUM, const float* MS, const bf16* CS, const float* NS,
                       const float* h_norm_w, bf16* MIXED, LAS unsigned char* lds, int tid) {
    const int wave = __builtin_amdgcn_readfirstlane(tid >> 6), lane = tid & 63, g = lane >> 4, li = lane & 15;
    const int b = u >> 7, hh = (u >> 5) & 3, c = u & 31, m0 = b * SEQ + c * 128;
    LAS bf16* Vs = (LAS bf16*)(lds + MO_VS);
    LAS float* sc = (LAS float*)(lds + MO_SC);
    const float ms = MS[u];
    float us = 0.f, pm = 0.f, bq = 0.f;
    if (tid < 128) {
        bq = BCUM[(size_t)(m0 + tid) * 4 + hh]; us = GATES[(size_t)(m0 + tid) * 8 + hh] - bq;
        float v = us;
#pragma unroll
        for (int o = 1; o < 64; o <<= 1) { const float t = __shfl_up(v, o); if (lane >= o) v = fmaxf(v, t); }
        pm = v;
        if (tid == 63) sc[512] = v;
        sc[384 + tid] = NS[(size_t)u * 128 + tid];
    }
    __syncthreads();
    if (tid < 128) { if (tid >= 64) pm = fmaxf(pm, sc[512]); sc[tid] = us; sc[128 + tid] = fmaxf(ms, pm); sc[256 + tid] = bq; }
    LAS bf16* Cs = (LAS bf16*)(lds + MO_CS);
    {
        v4u tv[8], tc[8];
#pragma unroll
        for (int i = 0; i < 8; ++i) { const int id = tid + NTHR * i; tv[i] = *(const v4u*)(PROJ + (size_t)(m0 + (id >> 5)) * NPROJ + C_MV + hh * 256 + (id & 31) * 8);
            tc[i] = *(const v4u*)(CS + (size_t)u * 32768 + (size_t)id * 8); }
#pragma unroll
        for (int i = 0; i < 8; ++i) { const int id = tid + NTHR * i; *(LAS v4u*)(Vs + (id >> 5) * 264 + (id & 31) * 8) = tv[i]; *(LAS v4u*)(Cs + (id >> 4) * 136 + (id & 15) * 8) = tc[i]; }
    }
    __syncthreads();
    const int q = 16 * wave + li;
    const float Mq = sc[128 + q], einter = expf(ms - Mq);
    bf16x8 qf[4], qs[4]; float qd = 0.f;
    { const bf16* qp = QKC + (size_t)(m0 + q) * 1024 + hh * 128 + 8 * g;
#pragma unroll
      for (int ks = 0; ks < 4; ++ks) { const v4u a = *(const v4u*)(qp + 32 * ks); qf[ks] = __builtin_bit_cast(bf16x8, a);
          const float f[8] = {bflo(a.x), bfhi(a.x), bflo(a.y), bfhi(a.y), bflo(a.z), bfhi(a.z), bflo(a.w), bfhi(a.w)};
          const LAS float* nsp = sc + 384 + 32 * ks + 8 * g;
#pragma unroll
          for (int j = 0; j < 8; ++j) qd += f[j] * nsp[j];
          v4u o; o.x = pk2(f[0] * einter, f[1] * einter); o.y = pk2(f[2] * einter, f[3] * einter); o.z = pk2(f[4] * einter, f[5] * einter); o.w = pk2(f[6] * einter, f[7] * einter);
          qs[ks] = __builtin_bit_cast(bf16x8, o); } }
    qd += __shfl_xor(qd, 16); qd += __shfl_xor(qd, 32);
    f32x4 S[8]; float psum = 0.f;
#pragma unroll
    for (int st = 0; st < 8; ++st) S[st] = (f32x4){0.f, 0.f, 0.f, 0.f};
#pragma unroll
    for (int bt = 0; bt < 4; ++bt) {
        if (2 * bt <= wave) {
            bf16x8 kfr[2][4];
#pragma unroll
            for (int t4 = 0; t4 < 2; ++t4) { const bf16* kp = QKC + (size_t)(m0 + 16 * (2 * bt + t4) + li) * 1024 + 512 + hh * 128 + 8 * g;
#pragma unroll
                for (int ks = 0; ks < 4; ++ks) kfr[t4][ks] = *(const bf16x8*)(kp + 32 * ks); }
#pragma unroll
            for (int t4 = 0; t4 < 2; ++t4) { const int st = 2 * bt + t4;
#pragma unroll
                for (int ks = 0; ks < 4; ++ks) S[st] = MFMA16(kfr[t4][ks], qf[ks], S[st]);
#pragma unroll
                for (int e = 0; e < 4; ++e) { const int s = 16 * st + 4 * g + e; const float wgt = (s <= q) ? expf(sc[s] - Mq) : 0.f; const float pv = S[st][e] * wgt; S[st][e] = pv; psum += pv; } }
        }
    }
    psum += __shfl_xor(psum, 16); psum += __shfl_xor(psum, 32);
    const float den = einter * qd + psum;
    const float inv = 1.f / fmaxf(fabsf(den), expf(-(sc[256 + q] + Mq)));
    bf16x8 pf[4];
#pragma unroll
    for (int s2 = 0; s2 < 4; ++s2) { v4u w; w.x = pk2(S[2 * s2][0], S[2 * s2][1]); w.y = pk2(S[2 * s2][2], S[2 * s2][3]); w.z = pk2(S[2 * s2 + 1][0], S[2 * s2 + 1][1]); w.w = pk2(S[2 * s2 + 1][2], S[2 * s2 + 1][3]);
        pf[s2] = __builtin_bit_cast(bf16x8, w); }
    f32x4 acc[16];
    const LAS bf16* csb = Cs + li * 136 + 8 * g;
#pragma unroll
    for (int vt = 0; vt < 16; ++vt) {
        f32x4 a = {0.f, 0.f, 0.f, 0.f};
#pragma unroll
        for (int ks = 0; ks < 4; ++ks) a = MFMA16(*(const LAS bf16x8*)(csb + vt * 16 * 136 + 32 * ks), qs[ks], a);
        acc[vt] = a;
    }
#pragma unroll
    for (int s2 = 0; s2 < 4; ++s2) {
        if (2 * s2 <= wave) {
#pragma unroll
            for (int vt = 0; vt < 16; ++vt) { const LAS bf16* p = Vs + (32 * s2 + 4 * g + (li >> 2)) * 264 + 16 * vt + 4 * (li & 3);
                acc[vt] = MFMA16(mk8(tr_read(p), tr_read(p + 16 * 264)), pf[s2], acc[vt]); }
        }
    }
#pragma unroll
    for (int vt = 0; vt < 16; ++vt) acc[vt] = acc[vt] * inv;
    float ssq = 0.f;
#pragma unroll
    for (int vt = 0; vt < 16; ++vt) ssq += (acc[vt][0] * acc[vt][0] + acc[vt][1] * acc[vt][1]) + (acc[vt][2] * acc[vt][2] + acc[vt][3] * acc[vt][3]);
    ssq += __shfl_xor(ssq, 16); ssq += __shfl_xor(ssq, 32);
    const float rstd = rsqrtf(ssq * (1.f / 256.f) + EPS);
    const bf16* mo = PROJ + (size_t)(m0 + q) * NPROJ + C_MO + hh * 256 + 4 * g;
    bf16* dst = MIXED + (size_t)(m0 + q) * DM + 1024 + hh * 256 + 4 * g;
    const float* hw = h_norm_w + l * 1024 + hh * 256 + 4 * g;
#pragma unroll
    for (int vt = 0; vt < 16; ++vt) { const v2u og = *(const v2u*)(mo + 16 * vt); const f32x4 w = *(const f32x4*)(hw + 16 * vt);
        v2u o; o.x = pk2(acc[vt][0] * rstd * w.x * sigmoidf_(bflo(og.x)), acc[vt][1] * rstd * w.y * sigmoidf_(bfhi(og.x)));
        o.y = pk2(acc[vt][2] * rstd * w.z * sigmoidf_(bflo(og.y)), acc[vt][3] * rstd * w.w * sigmoidf_(bfhi(og.y)));
        *(v2u*)(dst + 16 * vt) = o; }
    __syncthreads();
}

namespace pg8 {
struct EpiRes {
    static constexpr bool PERM = true, AFTER_DRAIN = false;
    const float* xin; float* xout; const float* gate;
    __device__ __forceinline__ void operator()(const f32x4 (&acc)[2][2][4][2], const Unit& u, int wr, int wc, int fr, int fq) const {
        const int row0 = u.pm * BM + wr * 64 + fr, col0 = u.pn * BM + wc * 32 + 8 * fq, b = (u.pm * BM) >> 12;
        f32x4 gv[2][2];
#pragma unroll
        for (int bj = 0; bj < 2; ++bj)
#pragma unroll
            for (int n = 0; n < 2; ++n) gv[bj][n] = *(const f32x4*)(gate + (size_t)b * 12288 + col0 + bj * HALF + 4 * n);
#pragma unroll
        for (int ai = 0; ai < 2; ++ai) {
            f32x4 xr[4][2][2];
#pragma unroll
            for (int m = 0; m < 4; ++m)
#pragma unroll
                for (int bj = 0; bj < 2; ++bj)
#pragma unroll
                    for (int n = 0; n < 2; ++n) xr[m][bj][n] = *(const f32x4*)(xin + (size_t)(row0 + ai * HALF + m * 16) * 2048 + col0 + bj * HALF + 4 * n);
#pragma unroll
            for (int m = 0; m < 4; ++m)
#pragma unroll
                for (int bj = 0; bj < 2; ++bj)
#pragma unroll
                    for (int n = 0; n < 2; ++n) *(f32x4*)(xout + (size_t)(row0 + ai * HALF + m * 16) * 2048 + col0 + bj * HALF + 4 * n) = xr[m][bj][n] + gv[bj][n] * acc[ai][bj][m][n];
        }
    }
};
struct EpiProj {
    static constexpr bool PERM = true, AFTER_DRAIN = false;
    bf16_t* O; bf16_t* VHp;
    __device__ __forceinline__ void operator()(const f32x4 (&acc)[2][2][4][2], const Unit& u, int wr, int wc, int fr, int fq) const {
        const int row0 = u.pm * BM + wr * 64 + fr, col0 = u.pn * BM + wc * 32 + 8 * fq;
        const bool isv = (u.pn >= 8 && u.pn < 12);
#pragma unroll
        for (int ai = 0; ai < 2; ++ai)
#pragma unroll
            for (int m = 0; m < 4; ++m) { const int row = row0 + ai * HALF + m * 16;
#pragma unroll
                for (int bj = 0; bj < 2; ++bj) { const f32x4 v0 = acc[ai][bj][m][0], v1 = acc[ai][bj][m][1]; const int col = col0 + bj * HALF;
                    u32x4 w; w.x = cvt_pk_bf16(v0[0], v0[1]); w.y = cvt_pk_bf16(v0[2], v0[3]); w.z = cvt_pk_bf16(v1[0], v1[1]); w.w = cvt_pk_bf16(v1[2], v1[3]);
                    bf16_t* dst = isv ? VHp + ((size_t)((row >> 12) * 16 + ((col - 2048) >> 6)) * 4096 + (row & 4095)) * 64 + (col & 63) : O + (size_t)row * 6144 + col;
                    *(u32x4*)dst = w; } }
    }
};
struct EpiGlu {
    static constexpr bool PERM = true, AFTER_DRAIN = false;
    bf16_t* act;
    __device__ __forceinline__ void operator()(const f32x4 (&acc)[2][2][4][2], const Unit& u, int wr, int wc, int fr, int fq) const {
        const int row0 = u.pm * BM + wr * 64 + fr, col0 = (u.pn & 7) * 128 + wc * 32 + 8 * fq;
#pragma unroll
        for (int ai = 0; ai < 2; ++ai)
#pragma unroll
            for (int m = 0; m < 4; ++m) {
                float o[8];
#pragma unroll
                for (int n = 0; n < 2; ++n)
#pragma unroll
                    for (int j = 0; j < 4; ++j) { const float gt = acc[ai][0][m][n][j], up = acc[ai][1][m][n][j]; o[4 * n + j] = gt / (1.f + __expf(-gt)) * up; }
                u32x4 w; w.x = cvt_pk_bf16(o[0], o[1]); w.y = cvt_pk_bf16(o[2], o[3]); w.z = cvt_pk_bf16(o[4], o[5]); w.w = cvt_pk_bf16(o[6], o[7]);
                *(u32x4*)(act + (size_t)(row0 + ai * HALF + m * 16) * 1024 + col0) = w; }
    }
};
struct MoeOrder {
    int nunits, G, c; const PG8_LAS unsigned char* tile_e;
    __device__ __forceinline__ bool next(int i, Unit& u) const { const int L = i * G + c; if (L >= nunits) return false; const int rt = L >> 3; u.pm = rt; u.pn = (int)tile_e[rt] * 8 + (L & 7); return true; }
    __device__ __forceinline__ void a_ready(const Unit&) const {}
    __device__ __forceinline__ void done(const Unit&) const {}
};
}


#ifndef GEMM_ALIGN
#define GEMM_ALIGN false
#endif
#ifndef GEMM_ALIGN_IN
#define GEMM_ALIGN_IN GEMM_ALIGN
#endif
#ifndef GEMM_ALIGN_OUT
#define GEMM_ALIGN_OUT GEMM_ALIGN
#endif
#ifndef GEMM_ALIGN_UP
#define GEMM_ALIGN_UP GEMM_ALIGN
#endif
#ifndef GEMM_ALIGN_DN
#define GEMM_ALIGN_DN GEMM_ALIGN
#endif
__device__ __forceinline__ void gemm_in(LAS unsigned char* lds, const bf16* A, const bf16* Bt, bf16* O, bf16* VHp, int G, int bx) {
    pg8::Gemm g{A, Bt, T, NPROJ, DM}; pg8::StaticOrder S; S.init(T, NPROJ, G, bx);
    pg8::EpiProj E{O, VHp};
    pg8::gemm_phase<pg8::EpiProj, pg8::StaticOrder, GEMM_ALIGN_IN, true>(lds, g, S, E);
}
__device__ __forceinline__ void gemm_out(LAS unsigned char* lds, const bf16* A, const bf16* Bt, const float* xin, float* xout, const float* gate, int G, int bx) {
    pg8::Gemm g{A, Bt, T, DM, DM}; pg8::StaticOrder S; S.init(T, DM, G, bx);
    pg8::EpiRes E{xin, xout, gate};
    pg8::gemm_phase<pg8::EpiRes, pg8::StaticOrder, GEMM_ALIGN_OUT, true>(lds, g, S, E);
}
__device__ __forceinline__ void gemm_up(LAS unsigned char* lds, const bf16* A, const int* rowtok, const bf16* Bt, bf16* act, int nt, int G, int bx) {
    pg8::MoeOrder S{nt * 8, G, bx, (const LAS unsigned char*)(lds + LDS_TILE)};
    pg8::Gemm g{A, Bt, HS_ROWS, NEXP * 2048, DM, rowtok};
    pg8::EpiGlu E{act};
    pg8::gemm_phase<pg8::EpiGlu, pg8::MoeOrder, GEMM_ALIGN_UP, true, true>(lds, g, S, E);
}
__device__ __forceinline__ void gemm_down(LAS unsigned char* lds, const bf16* A, const bf16* Bt, bf16* O, int nt, int G, int bx) {
    pg8::MoeOrder S{nt * 8, G, bx, (const LAS unsigned char*)(lds + LDS_TILE)};
    pg8::Gemm g{A, Bt, HS_ROWS, NEXP * 2048, FFE};
    pg8::EpiBf16<0> E{O, DM, nullptr, 2048, 0, 1.f};
    pg8::gemm_phase<pg8::EpiBf16<0>, pg8::MoeOrder, GEMM_ALIGN_DN, true>(lds, g, S, E);
}

constexpr int PH_PER_LAYER = 11, N_PHASES = 1 + NLAYER * PH_PER_LAYER + 1;
struct Args { const float* in[21]; float* out; unsigned char* ws; int ph_lo, ph_hi; };
__global__ void __launch_bounds__(NTHR, 2) fwd(Args args) {
    extern __shared__ __attribute__((aligned(16))) unsigned char lds_raw[];
    LAS unsigned char* lds = (LAS unsigned char*)lds_raw;
    const int tid = threadIdx.x;
    const int G = gridDim.x, bx = blockIdx.x, vcu = (G % 8 == 0) ? (bx % 8) * (G / 8) + bx / 8 : bx;
#define KAS __attribute__((address_space(4)))
#define P_IN(i) (*(const float* const KAS*)(ka + 8 * (i)))
#define P_WS (*(unsigned char* const KAS*)(ka + 176))
#define P_X (*(float* const KAS*)(ka + 168))
#define P_F(off) ((float*)(P_WS + (off)))
#define P_I(off) ((int*)(P_WS + (off)))
#define P_B(off) ((bf16*)(P_WS + (off)))
#define x_in P_IN(0)
#define cvec P_IN(1)
#define rel_bias P_IN(2)
#define w_mod P_IN(3)
#define b_mod P_IN(4)
#define norm1_w P_IN(5)
#define norm2_w P_IN(6)
#define w_in P_IN(7)
#define q_norm_w P_IN(8)
#define k_norm_w P_IN(9)
#define conv_w P_IN(10)
#define gate_b P_IN(11)
#define h_norm_w P_IN(12)
#define w_out P_IN(13)
#define rgw P_IN(14)
#define rgb P_IN(15)
#define rew P_IN(16)
#define reb P_IN(17)
#define w_gate P_IN(18)
#define w_up P_IN(19)
#define w_down P_IN(20)
#define X P_X
#define MOD P_F(WS_MOD)
#define GATES P_F(WS_GATES)
#define BCUM P_F(WS_BCUM)
#define CG P_F(WS_SMALL + SM_CG)
#define CM P_F(WS_SMALL + SM_CM)
#define MS P_F(WS_SMALL + SM_MS)
#define HIST P_I(WS_SMALL + SM_HIST)
#define TILE P_I(WS_SMALL + SM_TILE)
#define WRT P_F(WS_SMALL + SM_WRT)
#define BTG P_F(WS_SMALL + SM_BTG)
#define TOKE P_I(WS_TOK + TK_E)
#define TOKW P_F(WS_TOK + TK_W)
#define TOKR P_I(WS_TOK + TK_R)
#define TOKD P_I(WS_TOK + TK_D)
#define NLOC P_F(WS_NLOC)
#define NS P_F(WS_NS)
#define WIN P_B(WS_WIN)
#define WOUT P_B(WS_WOUT)
#define WGU P_B(WS_WGU)
#define WD P_B(WS_WD)
#define H P_B(WS_H)
#define PROJ P_B(WS_PROJ)
#define QKC P_B(WS_QKC)
#define MIXED P_B(WS_MIXED)
#define CL P_F(WS_CL)
#define CS P_B(WS_CS)
#define HS P_B(WS_HS)
#define ACT P_B(WS_ACT)
#define OROWS P_B(WS_OROWS)
#define ROWTOK P_I(WS_ROWTOK)
#define KH P_B(WS_KH)
#define VH P_B(WS_VH)
#define QN P_B(WS_QN)
    if (tid < 4) ((LAS unsigned*)(lds + LDS_BARW))[tid] = 0u;
    __syncthreads();
    const int lo = args.ph_lo, hi = args.ph_hi;
    XcdBarrier bar; bar.bar = (unsigned*)(args.ws + WS_CTL) + CW_BAR; bar.x = 0; bar.st = nullptr;
    if (hi - lo > 1) bar = xcd_barrier_post((unsigned*)(args.ws + WS_CTL) + CW_BAR, (volatile LAS unsigned*)(lds + LDS_BARW));
#ifndef ENMASK
#define ENMASK 0xFFF
#endif
#define EN(j) ((ENMASK >> (j)) & 1)
#ifndef REPMASK
#define REPMASK 0
#endif
#ifndef REPL0
#define REPL0 0
#endif
#define NREP(j) ((((REPMASK >> (j)) & 1) || (((REPL0 >> (j)) & 1) && l == 0)) ? 2 : 1)
#define IN(k) (lo <= (k) && (k) < hi)
#define PTID int tp = tid; asm volatile("" : "+v"(tp)); const KAS char* ka = (const KAS char*)__builtin_amdgcn_kernarg_segment_ptr(); asm volatile("" : "+s"(ka))
#define SEAM(k) do { if ((k) + 1 < hi) xcd_barrier(bar); } while (0)

    if (EN(11) && IN(0)) {
        PTID;
        for (int rep_ = 0; rep_ < (((REPMASK >> 11) & 1) ? 2 : 1); ++rep_) {
        p0_mod(cvec, w_mod, b_mod, MOD, lds, vcu, G, tp);
        p0_convert(w_in, w_out, w_gate, w_up, w_down, rgw, rew, WRT, rel_bias, BTG, WIN, WOUT, WGU, WD, lds, vcu, G, tp); if (rep_ == 0 && ((REPMASK >> 11) & 1)) __syncthreads(); }
        SEAM(0);
    }
#pragma unroll 1
    for (int l = 0; l < NLAYER; ++l) {
        const int pb = 1 + PH_PER_LAYER * l;
        if (EN(0) && IN(pb + 0)) {
            PTID;
for (int rep_ = 0; rep_ < NREP(0); ++rep_) { phase_a(l == 0 ? 0 : 1, l, l == 0 ? x_in : X, X, MOD, norm1_w, w_in, gate_b, TOKD, TOKW, OROWS, H, GATES, lds, vcu, G, tp); if (NREP(0) > 1) __syncthreads(); }
            SEAM(pb + 0);
        }
        if (EN(1) && IN(pb + 1)) {
            PTID;
for (int rep_ = 0; rep_ < NREP(1); ++rep_) { gemm_in(lds, H, WIN + (size_t)l * NPROJ * DM, PROJ, VH, G, bx); if (NREP(1) > 1) __syncthreads(); }
            SEAM(pb + 1);
        }
        if (EN(2) && IN(pb + 2)) {
            PTID;
            for (int rep_ = 0; rep_ < NREP(2); ++rep_) phase_c0(l, PROJ, QKC, KH, QN, q_norm_w, k_norm_w, conv_w, vcu, G, tp);
            SEAM(pb + 2);
        }
        if (EN(3) && IN(pb + 3)) {
            PTID;
#ifdef ATT_PROBE
            for (int un = vcu; un < NB * 16 * 16; un += G) attn_unit<ATT_PROBE>(un >> 8, (un >> 4) & 15, un & 15, QN, KH, VH, MIXED, BTG, lds, tp);
#endif
            for (int rep_ = 0; rep_ < (((REPMASK >> 12) & 1) ? 2 : 1); ++rep_)
            if (!((ENMASK >> 14) & 1))
            for (int un = vcu; un < NB * 16 * 16; un += G) attn_unit<0>(un >> 8, (un >> 4) & 15, un & 15, QN, KH, VH, MIXED, BTG, lds, tp);
            for (int rep_ = 0; rep_ < (((REPMASK >> 13) & 1) ? 2 : 1); ++rep_)
            if (!((ENMASK >> 15) & 1))
            for (int un = vcu; un < 512; un += G) mlstm_local_unit(un, PROJ, QKC, GATES, BCUM, CG, CM, CL, NLOC, lds, tp);
            SEAM(pb + 3);
        }
        if (EN(4) && IN(pb + 4)) {
            PTID;
for (int rep_ = 0; rep_ < NREP(4); ++rep_) { phase_d(CG, CM, MS, CL, CS, NLOC, NS, lds, vcu, G, tp); if (NREP(4) > 1) __syncthreads(); }
            SEAM(pb + 4);
        }
        if (EN(5) && IN(pb + 5)) {
            PTID;
for (int rep_ = 0; rep_ < NREP(5); ++rep_) { for (int un = vcu; un < 512; un += G) mlstm_out_unit(l, un, PROJ, QKC, GATES, BCUM, MS, CS, NS, h_norm_w, MIXED, lds, tp); if (NREP(5) > 1) __syncthreads(); }
            SEAM(pb + 5);
        }
        if (EN(6) && IN(pb + 6)) {
            PTID;
for (int rep_ = 0; rep_ < NREP(6); ++rep_) { gemm_out(lds, MIXED, WOUT + (size_t)l * DM * DM, l == 0 ? x_in : X, X, MOD + (size_t)l * NB * MODW + 2 * DM, G, bx); if (NREP(6) > 1) __syncthreads(); }
            SEAM(pb + 6);
        }
        if (EN(7) && IN(pb + 7)) {
            PTID;
for (int rep_ = 0; rep_ < NREP(7); ++rep_) { phase_g(l, X, MOD, norm2_w, rgw + (size_t)l * DM * 4, rgb + l * 4, rew + (size_t)l * DM * 32, reb + l * 32, WRT, H, TOKE, TOKW, TOKR, HIST, lds, vcu, G, tp); if (NREP(7) > 1) __syncthreads(); }
            SEAM(pb + 7);
        }
        if (EN(8) && IN(pb + 8)) {
            PTID;
for (int rep_ = 0; rep_ < NREP(8); ++rep_) { phase_h0(HIST, TOKE, TOKR, TOKD, ROWTOK, TILE, lds, vcu, G, tp); if (NREP(8) > 1) __syncthreads(); }
            SEAM(pb + 8);
        }
        if ((EN(9) || EN(10)) && (IN(pb + 9) || IN(pb + 10))) {
            PTID;
            const int nt = TILE[0];
            for (int i = tp; i < MAXTILES; i += NTHR) ((LAS unsigned char*)(lds + LDS_TILE))[i] = (unsigned char)(i < nt ? TILE[1 + i] : 0);
            __syncthreads();
            if (EN(9) && IN(pb + 9)) {
for (int rep_ = 0; rep_ < NREP(9); ++rep_) { gemm_up(lds, H, ROWTOK, WGU + (size_t)l * NEXP * 2048 * DM, ACT, nt, G, bx); if (NREP(9) > 1) __syncthreads(); }
                SEAM(pb + 9);
            }
            if (EN(10) && IN(pb + 10)) {
for (int rep_ = 0; rep_ < NREP(10); ++rep_) { gemm_down(lds, ACT, WD + (size_t)l * NEXP * DM * FFE, OROWS, nt, G, bx); if (NREP(10) > 1) __syncthreads(); }
                SEAM(pb + 10);
            }
        }
    }
    if (IN(N_PHASES - 1)) {
        PTID;
        phase_a(2, NLAYER, X, X, MOD, norm1_w, w_in, gate_b, TOKD, TOKW, OROWS, H, GATES, lds, vcu, G, tp);
    }
#undef IN
#undef SEAM
#undef x_in
#undef cvec
#undef rel_bias
#undef w_mod
#undef b_mod
#undef norm1_w
#undef norm2_w
#undef w_in
#undef q_norm_w
#undef k_norm_w
#undef conv_w
#undef gate_b
#undef h_norm_w
#undef w_out
#undef rgw
#undef rgb
#undef rew
#undef reb
#undef w_gate
#undef w_up
#undef w_down
#undef X
#undef MOD
#undef GATES
#undef BCUM
#undef CG
#undef CM
#undef MS
#undef HIST
#undef TILE
#undef WRT
#undef BTG
#undef TOKE
#undef TOKW
#undef TOKR
#undef TOKD
#undef NLOC
#undef NS
#undef WIN
#undef WOUT
#undef WGU
#undef WD
#undef H
#undef PROJ
#undef QKC
#undef MIXED
#undef CL
#undef CS
#undef HS
#undef ACT
#undef OROWS
#undef ROWTOK
#undef KH
#undef VH
#undef QN
}

#ifndef MK_SPLIT
#define MK_SPLIT 0
#endif
extern "C" void kernel_launch(void* const* d_in, const int* in_sizes, int n_in, void* d_out, int out_size, void* d_ws, size_t ws_size, hipStream_t stream) {
    static int grid = 0;
    if (grid == 0) {
        if (n_in != 21 || out_size != T * DM || ws_size < WS_END) { fprintf(stderr, "kernel_launch: unexpected shapes (n_in %d, out %d, ws %zu)\n", n_in, out_size, ws_size); grid = -1; return; }
        int dev = 0, cus = 0, per_cu = 0;
        if (hipGetDevice(&dev) != hipSuccess || hipDeviceGetAttribute(&cus, hipDeviceAttributeMultiprocessorCount, dev) != hipSuccess) { grid = -1; return; }
        if (hipFuncSetAttribute((const void*)fwd, hipFuncAttributeMaxDynamicSharedMemorySize, LDS_BYTES) != hipSuccess) { fprintf(stderr, "kernel_launch: hipFuncSetAttribute failed\n"); grid = -1; return; }
        if (hipOccupancyMaxActiveBlocksPerMultiprocessor(&per_cu, (const void*)fwd, NTHR, LDS_BYTES) != hipSuccess || per_cu < 1) { fprintf(stderr, "kernel_launch: occupancy query says %d\n", per_cu); }
        (void)hipGetLastError();
        grid = 1; while (grid * 2 <= cus) grid *= 2;
    }
    if (grid < 0) return;
    if (hipMemsetAsync((char*)d_ws + WS_CTL, 0, CTL_ZERO_BYTES, stream) != hipSuccess) return;
    Args a{};
    for (int i = 0; i < 21; ++i) a.in[i] = (const float*)d_in[i];
    a.out = (float*)d_out; a.ws = (unsigned char*)d_ws;
#if MK_SPLIT
    for (int p = 0; p < N_PHASES; ++p) { a.ph_lo = p; a.ph_hi = p + 1; hipLaunchKernelGGL(fwd, dim3(grid), dim3(NTHR), LDS_BYTES, stream, a); }
#else
    a.ph_lo = 0; a.ph_hi = N_PHASES;
    hipLaunchKernelGGL(fwd, dim3(grid), dim3(NTHR), LDS_BYTES, stream, a);
#endif
}
```

```cpp
#include <hip/hip_runtime.h>
#include <cstdio>
#include <cstdint>
#ifndef PG8_WGM
#define PG8_WGM 4
#endif
namespace pg8 {
#define PG8_LAS __attribute__((address_space(3)))
typedef unsigned short bf16_t;
typedef short bf16x8 __attribute__((ext_vector_type(8)));
typedef float f32x4 __attribute__((ext_vector_type(4)));
typedef unsigned u32x4 __attribute__((ext_vector_type(4)));
constexpr int BM = 256, BK = 64, HALF = 128, HTB = HALF * BK * 2  , STAGE_BYTES = 8 * HTB, NXCD = 8, WGM = PG8_WGM;

__host__ __device__ __forceinline__ int lds_byte(int r, int c) { const int st = (r >> 4) * 2 + (c >> 5), rr = r & 15, cc = c & 31, ob = rr * 64 + cc * 2; return st * 1024 + (ob ^ (((ob >> 9) & 1) << 5)); }
__host__ __device__ __forceinline__ void stage_rc(int b, int& R, int& C) { const int st = b / 1024, sb = b % 1024, swz = sb ^ (((sb >> 9) & 1) << 5); R = (st >> 1) * 16 + swz / 64; C = (st & 1) * 32 + (swz % 64) / 2; }
__host__ __device__ __forceinline__ int perm32(int rho) { const int n = rho >> 4, i = rho & 15; return 8 * (i >> 2) + 4 * n + (i & 3); }

struct Unit { int pm, pn; };
struct Gemm { const bf16_t* A; const bf16_t* Bt; int M, N, K; const int* rt = nullptr; };

struct StaticOrder {
    int nM, nN, nwg, G, c;
    __host__ __device__ void init(int M, int N, int G_, int c_) { nM = M / BM; nN = N / BM; nwg = nM * nN; G = G_; c = c_; }
    __host__ __device__ bool next(int i, Unit& u) const {
        const long L = (long)i * G + c; if (L >= nwg) return false;
        int wgid = (int)L; { const int q = nwg / NXCD, r = nwg % NXCD, xcd = wgid % NXCD, off = wgid / NXCD; wgid = (xcd < r ? xcd * (q + 1) : r * (q + 1) + (xcd - r) * q) + off; }
        const int nig = WGM * nN, gid = wgid / nig, fm = gid * WGM, gsz = (nM - fm) < WGM ? (nM - fm) : WGM;
        u.pm = fm + ((wgid % nig) % gsz); u.pn = (wgid % nig) / gsz; return true;
    }
    __device__ __forceinline__ void a_ready(const Unit&) const {}
    __device__ __forceinline__ void done(const Unit&) const {}
};

__device__ __forceinline__ unsigned cvt_pk_bf16(float lo, float hi) { unsigned r; asm volatile("v_cvt_pk_bf16_f32 %0, %1, %2" : "=v"(r) : "v"(lo), "v"(hi)); return r; }
typedef float f32x2 __attribute__((ext_vector_type(2)));
__device__ __forceinline__ f32x2 gelu_pk(f32x2 v) {
    const f32x2 av = __builtin_elementwise_abs(v), d = av * 0.2316418882f + 1.0f;
    f32x2 t; t.x = __builtin_amdgcn_rcpf(d.x); t.y = __builtin_amdgcn_rcpf(d.y);
    f32x2 q = t * 0.5307027145f + (-0.7265760135f); q = q * t + 0.7107068705f; q = q * t + (-0.142248368f); q = q * t + 0.127414796f; q = q * t;
    const f32x2 s = (v * v) * (-0.72134752044f);
    f32x2 e; e.x = __builtin_amdgcn_exp2f(s.x); e.y = __builtin_amdgcn_exp2f(s.y);
    const f32x2 m = v * (q * e), r = v - m;
    f32x2 o; o.x = v.x < 0.f ? m.x : r.x; o.y = v.y < 0.f ? m.y : r.y; return o;
}

template <int ACT  > struct EpiBf16 {
    static constexpr bool PERM = true, AFTER_DRAIN = false; static_assert(ACT == 0 || ACT == 1, "EpiBf16: ACT is 0 (none) or 1 (gelu_pk)");
    bf16_t* O; int ldc; const float* bias; int split_cols; size_t split_stride; float scale0;
    __device__ __forceinline__ void operator()(const f32x4 (&acc)[2][2][4][2], const Unit& u, int wr, int wc, int fr, int fq) const {
        const int row0 = u.pm * BM + wr * 64 + fr; int colt = u.pn * BM; bf16_t* base = O;
        float sc = 1.f; if (split_cols) { const int t = colt / split_cols; base += (size_t)t * split_stride; colt -= t * split_cols; if (t == 0) sc = scale0; }
        const int col0 = colt + wc * 32 + 8 * fq, bcol0 = u.pn * BM + wc * 32 + 8 * fq;
        f32x4 bv[2][2];
#pragma unroll
        for (int bj = 0; bj < 2; ++bj)
#pragma unroll
            for (int n = 0; n < 2; ++n) bv[bj][n] = bias ? *(const f32x4*)(bias + bcol0 + bj * HALF + 4 * n) : (f32x4){0.f, 0.f, 0.f, 0.f};
#pragma unroll
        for (int ai = 0; ai < 2; ++ai)
#pragma unroll
            for (int m = 0; m < 4; ++m) { bf16_t* rowp = base + (size_t)(row0 + ai * HALF + m * 16) * ldc + col0;
#pragma unroll
                for (int bj = 0; bj < 2; ++bj) { f32x4 v0 = acc[ai][bj][m][0] + bv[bj][0], v1 = acc[ai][bj][m][1] + bv[bj][1];
                    if (ACT == 1) { f32x2 a = gelu_pk((f32x2){v0[0], v0[1]}), b = gelu_pk((f32x2){v0[2], v0[3]}), c = gelu_pk((f32x2){v1[0], v1[1]}), d = gelu_pk((f32x2){v1[2], v1[3]});
                        v0 = (f32x4){a.x, a.y, b.x, b.y}; v1 = (f32x4){c.x, c.y, d.x, d.y}; }
                    v0 = v0 * sc; v1 = v1 * sc; u32x4 w; w.x = cvt_pk_bf16(v0[0], v0[1]); w.y = cvt_pk_bf16(v0[2], v0[3]); w.z = cvt_pk_bf16(v1[0], v1[1]); w.w = cvt_pk_bf16(v1[2], v1[3]);
                    *(u32x4*)(rowp + bj * HALF) = w; } }
    }
};
template <class Epi, class Sched, bool ALIGN_EPI = false, bool SP2 = false, bool GATHER = false>
__device__ __forceinline__ void gemm_phase(PG8_LAS unsigned char* lds, const Gemm g, const Sched& S, const Epi& E) {
    int tid_ = threadIdx.x; asm volatile("" : "+v"(tid_));
    const int tid = tid_, wid = __builtin_amdgcn_readfirstlane(tid >> 6), lane = tid & 63, wr = wid >> 2, wc = wid & 3, fr = lane & 15, fq = lane >> 4;
    const int K = g.K, nt = K / BK;
    unsigned voffA[2], voffB[2]; int Rr[2], Cc[2];
#pragma unroll
    for (int i = 0; i < 2; ++i) { int R, C; stage_rc(tid * 16 + i * 8192, R, C); const int Rb = Epi::PERM ? ((R & ~31) + perm32(R & 31)) : R; Rr[i] = R; Cc[i] = C;
        voffA[i] = (unsigned)(R * K + C) * 2u; voffB[i] = (unsigned)(Rb * K + C) * 2u; }
    unsigned gC[2][2] = {{0u, 0u}, {0u, 0u}}, gN[2][2] = {{0u, 0u}, {0u, 0u}};
#define PG8_GOFF(dst, U) do { _Pragma("unroll") for (int h_ = 0; h_ < 2; ++h_) _Pragma("unroll") for (int i_ = 0; i_ < 2; ++i_) \
        dst[h_][i_] = (unsigned)(g.rt[(U).pm * BM + h_ * HALF + Rr[i_]] * K + Cc[i_]) * 2u; } while (0)
#define PG8_STAGE_A(bufoff, p, h, nx) do { if constexpr (GATHER) { const unsigned vo_[2] = {(nx) ? gN[h][0] : gC[h][0], (nx) ? gN[h][1] : gC[h][1]}; PG8_STAGE(bufoff, p, vo_); } \
        else { PG8_STAGE(bufoff, (p) + (h) * hstep, voffA); } } while (0)
    const size_t kstep = (size_t)(BK * 2);
    const size_t hstep = (size_t)HALF * K * 2;
    const size_t tstep = 2 * hstep;
    const unsigned ldsw = (unsigned)wid * 1024u;
    const int aoff = lds_byte(wr * 64 + fr, fq * 8), boff = lds_byte(wc * 32 + fr, fq * 8);
#define PG8_SA(b, h) (((b) * 2 + (h)) * HTB)
#define PG8_SB(b, h) ((4 + (b) * 2 + (h)) * HTB)
#define PG8_STAGE(bufoff, gbase, voff) do { _Pragma("unroll") for (int _i = 0; _i < 2; ++_i) \
        __builtin_amdgcn_global_load_lds((const unsigned*)((const char*)(gbase) + (voff)[_i]), (PG8_LAS unsigned*)(lds + (bufoff) + ldsw + _i * 8192), 16, 0, 0); } while (0)
#define PG8_LDA(dst, b, h) do { _Pragma("unroll") for (int m = 0; m < 4; ++m) _Pragma("unroll") for (int k = 0; k < 2; ++k) dst[m][k] = *(const PG8_LAS bf16x8*)(lds + PG8_SA(b, h) + aoff + m * 2048 + k * 1024); } while (0)
#define PG8_LDB(dst, b, h) do { _Pragma("unroll") for (int n = 0; n < 2; ++n) _Pragma("unroll") for (int k = 0; k < 2; ++k) dst[n][k] = *(const PG8_LAS bf16x8*)(lds + PG8_SB(b, h) + boff + n * 2048 + k * 1024); } while (0)
#define PG8_MMA(ai, bj, At, Bt) do { __builtin_amdgcn_s_setprio(1); _Pragma("unroll") for (int m = 0; m < 4; ++m) _Pragma("unroll") for (int n = 0; n < 2; ++n) _Pragma("unroll") for (int k = 0; k < 2; ++k) \
        acc[ai][bj][m][n] = __builtin_amdgcn_mfma_f32_16x16x32_bf16(Bt[n][k], At[m][k], acc[ai][bj][m][n], 0, 0, 0); __builtin_amdgcn_s_setprio(0); } while (0)
#define PG8_WAIT_V(n) asm volatile("s_waitcnt vmcnt(" #n ")" ::: "memory")
#define PG8_WAIT_L(n) asm volatile("s_waitcnt lgkmcnt(" #n ")" ::: "memory")
#define PG8_BAR __builtin_amdgcn_s_barrier()
#define PG8_SCHED __builtin_amdgcn_sched_barrier(0)
    Unit cur, nxt; int ui = 0;
    if (!S.next(0, cur)) return;
    f32x4 acc[2][2][4][2];
#pragma unroll
    for (int a = 0; a < 2; ++a)
#pragma unroll
        for (int b = 0; b < 2; ++b)
#pragma unroll
            for (int m = 0; m < 4; ++m)
#pragma unroll
                for (int n = 0; n < 2; ++n) acc[a][b][m][n] = (f32x4){0.f, 0.f, 0.f, 0.f};
    bf16x8 At[4][2], B0[2][2], B1[2][2];
    const char* cA = (const char*)g.A + (GATHER ? (size_t)0 : (size_t)cur.pm * tstep); const char* cB = (const char*)g.Bt + (size_t)cur.pn * tstep;
    S.a_ready(cur);
    if constexpr (GATHER) { PG8_GOFF(gC, cur); asm volatile("s_waitcnt vmcnt(0)" ::: "memory"); }
    if constexpr (SP2) {
        PG8_STAGE(PG8_SB(0, 0), cB, voffB); PG8_STAGE(PG8_SB(0, 1), cB + hstep, voffB); PG8_STAGE_A(PG8_SA(0, 0), cA, 0, false); PG8_STAGE_A(PG8_SA(0, 1), cA, 1, false);
        if (wr == 1) PG8_BAR;
        PG8_WAIT_V(2); PG8_BAR;
        PG8_STAGE(PG8_SB(1, 0), cB + kstep, voffB); PG8_STAGE_A(PG8_SA(1, 0), cA + kstep, 0, false); PG8_STAGE(PG8_SB(1, 1), cB + hstep + kstep, voffB);
        PG8_WAIT_V(6); PG8_BAR;
    } else {
        PG8_STAGE(PG8_SB(0, 0), cB, voffB); PG8_STAGE(PG8_SA(0, 0), cA, voffA); PG8_STAGE(PG8_SB(0, 1), cB + hstep, voffB); PG8_STAGE(PG8_SA(0, 1), cA + hstep, voffA);
        if (wr == 1) PG8_BAR;
        PG8_WAIT_V(4); PG8_BAR;
        PG8_STAGE(PG8_SB(1, 0), cB + kstep, voffB); PG8_STAGE(PG8_SA(1, 0), cA + kstep, voffA); PG8_STAGE(PG8_SB(1, 1), cB + hstep + kstep, voffB);
        PG8_WAIT_V(6); PG8_BAR;
    }
    for (;;) {
        const bool has_next = S.next(ui + 1, nxt);
        if constexpr (GATHER) { if (has_next) { PG8_GOFF(gN, nxt); asm volatile("s_waitcnt vmcnt(0)" ::: "memory"); } }
        const char* nA = (has_next && !GATHER) ? (const char*)g.A + (size_t)nxt.pm * tstep : cA; const char* nB = has_next ? (const char*)g.Bt + (size_t)nxt.pn * tstep : cB;
        for (int t = 0; t < nt; t += 2) {
            const bool last = (t == nt - 2);
            const char* a1 = cA + (size_t)(t + 1) * kstep;
            const char* a2 = last ? nA : cA + (size_t)(t + 2) * kstep; const char* b2 = last ? nB : cB + (size_t)(t + 2) * kstep;
            const char* a3 = a2 + kstep; const char* b3 = b2 + kstep;
            const bool nxu = last && has_next;
            if (last && has_next) S.a_ready(nxt);
            if constexpr (SP2) {
            PG8_LDB(B0, 0, 0); PG8_LDB(B1, 0, 1); PG8_SCHED; PG8_LDA(At, 0, 0); PG8_STAGE_A(PG8_SA(1, 1), a1, 1, false);
            PG8_WAIT_V(8); PG8_WAIT_L(0); PG8_BAR; PG8_MMA(0, 0, At, B0); PG8_MMA(0, 1, At, B1); PG8_BAR; PG8_SCHED;
            PG8_LDA(At, 0, 1); PG8_STAGE(PG8_SB(0, 0), b2, voffB); PG8_STAGE(PG8_SB(0, 1), b2 + hstep, voffB); PG8_STAGE_A(PG8_SA(0, 0), a2, 0, nxu);
            PG8_WAIT_V(8); PG8_WAIT_L(0); PG8_BAR; PG8_MMA(1, 0, At, B0); PG8_MMA(1, 1, At, B1); PG8_BAR; PG8_SCHED;
            PG8_LDB(B0, 1, 0); PG8_LDB(B1, 1, 1); PG8_SCHED; PG8_LDA(At, 1, 0); PG8_STAGE_A(PG8_SA(0, 1), a2, 1, nxu);
            PG8_WAIT_V(8); PG8_WAIT_L(0); PG8_BAR; PG8_MMA(0, 0, At, B0); PG8_MMA(0, 1, At, B1); PG8_BAR; PG8_SCHED;
            PG8_LDA(At, 1, 1); PG8_STAGE(PG8_SB(1, 0), b3, voffB); PG8_STAGE(PG8_SB(1, 1), b3 + hstep, voffB); PG8_STAGE_A(PG8_SA(1, 0), a3, 0, nxu);
            PG8_WAIT_V(8); PG8_WAIT_L(0); PG8_BAR; PG8_MMA(1, 0, At, B0); PG8_MMA(1, 1, At, B1); PG8_BAR; PG8_SCHED;
            } else {
            PG8_LDB(B0, 0, 0); PG8_SCHED; PG8_LDA(At, 0, 0); PG8_STAGE(PG8_SA(1, 1), a1 + hstep, voffA);
            PG8_WAIT_L(8); PG8_BAR; PG8_WAIT_L(0); PG8_MMA(0, 0, At, B0); PG8_BAR; PG8_SCHED;
            PG8_LDB(B1, 0, 1); PG8_STAGE(PG8_SB(0, 0), b2, voffB);
            PG8_BAR; PG8_WAIT_L(0); PG8_MMA(0, 1, At, B1); PG8_BAR;
            PG8_LDA(At, 0, 1); PG8_STAGE(PG8_SA(0, 0), a2, voffA);
            PG8_BAR; PG8_WAIT_L(0); PG8_MMA(1, 0, At, B0); PG8_BAR; PG8_SCHED;
            PG8_STAGE(PG8_SB(0, 1), b2 + hstep, voffB);
            PG8_WAIT_V(6); PG8_BAR; PG8_MMA(1, 1, At, B1); PG8_BAR;
            PG8_LDB(B0, 1, 0); PG8_SCHED; PG8_LDA(At, 1, 0); PG8_STAGE(PG8_SA(0, 1), a2 + hstep, voffA);
            PG8_WAIT_L(8); PG8_BAR; PG8_WAIT_L(0); PG8_MMA(0, 0, At, B0); PG8_BAR; PG8_SCHED;
            PG8_LDB(B1, 1, 1); PG8_STAGE(PG8_SB(1, 0), b3, voffB);
            PG8_BAR; PG8_WAIT_L(0); PG8_MMA(0, 1, At, B1); PG8_BAR;
            PG8_LDA(At, 1, 1); PG8_STAGE(PG8_SA(1, 0), a3, voffA);
            PG8_BAR; PG8_WAIT_L(0); PG8_MMA(1, 0, At, B0); PG8_BAR; PG8_SCHED;
            PG8_STAGE(PG8_SB(1, 1), b3 + hstep, voffB);
            PG8_WAIT_V(6); PG8_BAR; PG8_MMA(1, 1, At, B1); PG8_BAR;
            }
        }
        if constexpr (ALIGN_EPI) { if (wr == 0) PG8_BAR; }
        if constexpr (!Epi::AFTER_DRAIN) { E(acc, cur, wr, wc, fr, fq); S.done(cur); }
        if (!has_next) break;
#pragma unroll
        for (int a = 0; a < 2; ++a)
#pragma unroll
            for (int b = 0; b < 2; ++b)
#pragma unroll
                for (int m = 0; m < 4; ++m)
#pragma unroll
                    for (int n = 0; n < 2; ++n) acc[a][b][m][n] = (f32x4){0.f, 0.f, 0.f, 0.f};
        cur = nxt; cA = nA; cB = nB; ++ui;
        if constexpr (GATHER) { _Pragma("unroll") for (int h_ = 0; h_ < 2; ++h_) _Pragma("unroll") for (int i_ = 0; i_ < 2; ++i_) gC[h_][i_] = gN[h_][i_]; }
        if constexpr (ALIGN_EPI) { if (wr == 1) PG8_BAR; }
    }
    PG8_WAIT_V(0);
    if constexpr (!ALIGN_EPI) { if (wr == 0) PG8_BAR; }
    PG8_BAR;
    if constexpr (Epi::AFTER_DRAIN) { E.fused(acc, cur, wr, wc, fr, fq, lds, wid, lane); S.done(cur); }
#undef PG8_SA
#undef PG8_GOFF
#undef PG8_STAGE_A
#undef PG8_SB
#undef PG8_STAGE
#undef PG8_LDA
#undef PG8_LDB
#undef PG8_MMA
#undef PG8_WAIT_V
#undef PG8_WAIT_L
#undef PG8_BAR
#undef PG8_SCHED
}
}

constexpr int NB = 4, SEQ = 4096, DM = 2048, T = NB * SEQ, NLAYER = 2;
constexpr int INW = 6152, NPROJ = 6144;
constexpr int C_AQ = 0, C_AK = 1024, C_AV = 2048, C_MQ = 3072, C_MK = 3584, C_MV = 4096, C_MO = 5120;
constexpr int NEXP = 32, FFE = 1024;
constexpr int MODW = 6 * DM;
constexpr float EPS = 1e-6f;
constexpr int MAXTILES = 160;
constexpr int HS_ROWS = MAXTILES * 256;
constexpr int NWAVES = 8, NTHR = 512;

constexpr size_t MiB = 1u << 20;
constexpr size_t WS_CTL = 0, CTL_ZERO_BYTES = 1 * MiB;
constexpr size_t WS_MOD = 1 * MiB;
constexpr size_t WS_GATES = 2 * MiB;
constexpr size_t WS_BCUM = 3 * MiB;
constexpr size_t WS_SMALL = 4 * MiB;
constexpr size_t WS_TOK = 5 * MiB;
constexpr size_t WS_NLOC = 6 * MiB;
constexpr size_t WS_NS = 7 * MiB;
constexpr size_t WS_ROWTOK = 7 * MiB + 512 * 1024;
constexpr size_t WS_WIN = 8 * MiB;
constexpr size_t WS_WOUT = 56 * MiB;
constexpr size_t WS_WGU = 72 * MiB;
constexpr size_t WS_WD = 584 * MiB;
constexpr size_t WS_H = 840 * MiB;
constexpr size_t WS_PROJ = 904 * MiB;
constexpr size_t WS_QKC = 1096 * MiB;
constexpr size_t WS_MIXED = 1128 * MiB;
constexpr size_t WS_CL = 1192 * MiB;
constexpr size_t WS_CS = 1256 * MiB;
constexpr size_t WS_HS = 1288 * MiB;
constexpr size_t WS_ACT = 1448 * MiB;
constexpr size_t WS_OROWS = 1528 * MiB;
constexpr size_t WS_KH = 1688 * MiB;
constexpr size_t WS_VH = 1720 * MiB;
constexpr size_t WS_QN = 1752 * MiB;
constexpr size_t WS_XB = 1784 * MiB;
constexpr size_t WS_END = 1848 * MiB;
constexpr size_t SM_CG = 0, SM_CM = 4096, SM_MS = 8192;
constexpr size_t SM_HIST = 16384;
constexpr size_t SM_TILE = 65536;
constexpr size_t SM_BTG = 917504;
constexpr size_t SM_WRT = 131072;
constexpr size_t TK_E = 0, TK_W = 128 * 1024, TK_R = 256 * 1024, TK_D = 384 * 1024;
constexpr int CW_BAR = 4096;

constexpr int RING_BYTES = 131072;
constexpr int LDS_BYTES = 147456;
constexpr int LDS_PERSIST = LDS_BYTES - 512;
constexpr int LDS_BARW = LDS_PERSIST;
constexpr int LDS_TILE = LDS_PERSIST + 64;
constexpr int LDS_NT = LDS_PERSIST + 256;

#define GAS __attribute__((address_space(1)))
#define LAS __attribute__((address_space(3)))
#define DI __device__ __forceinline__
typedef unsigned short bf16;
typedef unsigned v4u __attribute__((ext_vector_type(4)));
typedef unsigned v2u __attribute__((ext_vector_type(2)));
typedef float f32x4 __attribute__((ext_vector_type(4)));
typedef short bf16x8 __attribute__((ext_vector_type(8)));
typedef short s16x4 __attribute__((ext_vector_type(4)));
typedef GAS unsigned gu32;
#define RLX_AGENT __ATOMIC_RELAXED, __HIP_MEMORY_SCOPE_AGENT
#define LDS_WAIT() asm volatile("s_waitcnt lgkmcnt(0)" ::: "memory")
#define VM_WAIT() asm volatile("s_waitcnt vmcnt(0)" ::: "memory")
DI unsigned f2bf(float f) { unsigned u = __builtin_bit_cast(unsigned, f); return (u + 0x7fffu + ((u >> 16) & 1u)) >> 16; }
typedef float f32x2_t __attribute__((ext_vector_type(2))); typedef __bf16 bf16x2_t __attribute__((ext_vector_type(2)));
DI unsigned pk2(float lo, float hi) { f32x2_t v = {lo, hi}; bf16x2_t b = __builtin_convertvector(v, bf16x2_t); return __builtin_bit_cast(unsigned, b); }
DI float bf2f(unsigned v) { return __builtin_bit_cast(float, v << 16); }
DI float bflo(unsigned w) { return __builtin_bit_cast(float, w << 16); }
DI float bfhi(unsigned w) { return __builtin_bit_cast(float, w & 0xffff0000u); }
DI float wave_sum(float v) {
#pragma unroll
    for (int o = 1; o < 64; o <<= 1) v += __shfl_xor(v, o);
    return v;
}
DI float wave_max(float v) {
#pragma unroll
    for (int o = 1; o < 64; o <<= 1) v = fmaxf(v, __shfl_xor(v, o));
    return v;
}
DI float sigmoidf_(float x) { return 1.f / (1.f + __expf(-x)); }
DI float siluf_(float x) { return x / (1.f + __expf(-x)); }
DI float logsigmoidf_(float x) { return x >= 0.f ? -log1pf(expf(-x)) : x - log1pf(expf(x)); }
DI bf16x8 mk8(s16x4 a, s16x4 b) { bf16x8 r; r[0] = a[0]; r[1] = a[1]; r[2] = a[2]; r[3] = a[3]; r[4] = b[0]; r[5] = b[1]; r[6] = b[2]; r[7] = b[3]; return r; }
DI s16x4 tr_read(const LAS bf16* p) { typedef short v4i16_t __attribute__((ext_vector_type(4))); return __builtin_bit_cast(s16x4, __builtin_amdgcn_ds_read_tr16_b64_v4i16((LAS v4i16_t*)p)); }
#define MFMA16(a, b, c) __builtin_amdgcn_mfma_f32_16x16x32_bf16((a), (b), (c), 0, 0, 0)

__device__ const unsigned char BUCKET[3][132] = {
 {0,1,2,3,4,5,6,7,8,9,10,11,12,13,14,15,16,16,16,16,16,16,17,17,17,17,17,17,17,17,18,18,18,18,18,18,18,18,18,18,19,19,19,19,19,19,19,19,19,19,19,19,19,19,20,20,20,20,20,20,20,20,20,20,20,20,20,20,20,20,20,20,20,21,21,21,21,21,21,21,21,21,21,21,21,21,21,21,21,21,21,21,21,21,21,21,21,21,21,22,22,22,22,22,22,22,22,22,22,22,22,22,22,22,22,22,22,22,22,22,22,22,22,22,22,22,22,22,22,0,0,0},
 {0,4,8,12,16,16,17,17,18,18,19,19,19,19,20,20,20,20,20,21,21,21,21,21,21,22,22,22,22,22,22,22,22,22,23,23,23,23,23,23,23,23,23,23,23,23,24,24,24,24,24,24,24,24,24,24,24,24,24,24,24,24,25,25,25,25,25,25,25,25,25,25,25,25,25,25,25,25,25,25,25,25,25,26,26,26,26,26,26,26,26,26,26,26,26,26,26,26,26,26,26,26,26,26,26,26,26,26,26,26,26,26,26,27,27,27,27,27,27,27,27,27,27,27,27,27,27,27,27,0,0,0},
 {0,16,18,19,20,21,21,22,22,23,23,23,24,24,24,24,25,25,25,25,25,26,26,26,26,26,26,26,26,27,27,27,27,27,27,27,27,27,27,28,28,28,28,28,28,28,28,28,28,28,28,28,29,29,29,29,29,29,29,29,29,29,29,29,29,29,29,29,29,29,30,30,30,30,30,30,30,30,30,30,30,30,30,30,30,30,30,30,30,30,30,30,30,30,30,31,31,31,31,31,31,31,31,31,31,31,31,31,31,31,31,31,31,31,31,31,31,31,31,31,31,31,31,31,31,31,31,31,31,0,0,0}};
#define XB_TMO      128
#define XB_XCNT(j)  (256  + 64 * (j))
#define XB_XSUB(j)  (1280 + 64 * (j))
#define XB_XGEN(j)  (2304 + 64 * (j))
#define XB_TOP      3328
#define XB_TOPGEN   3392
#define XCD_BAR_WORDS 3456
#define XB_SPIN_CAP (1u << 18)

__device__ __forceinline__ unsigned xb_ld(unsigned* p)              { return __hip_atomic_load(p, __ATOMIC_RELAXED, __HIP_MEMORY_SCOPE_AGENT); }
__device__ __forceinline__ unsigned xb_add(unsigned* p, unsigned v) { return __hip_atomic_fetch_add(p, v, __ATOMIC_RELAXED, __HIP_MEMORY_SCOPE_AGENT); }
__device__ __forceinline__ unsigned xb_xcc_id() { return (unsigned)__builtin_amdgcn_s_getreg((3 << 11) | 20) & 0xFu; }
#define XB_SPIN(cond, bar) do { unsigned _sp = 0; while (cond) { __builtin_amdgcn_s_sleep(1); \
    if ((++_sp & 255u) == 0u) { if (xb_ld(&(bar)[XB_TMO])) break; if (_sp > XB_SPIN_CAP) { atomicAdd(&(bar)[XB_TMO], 1u); break; } } } } while (0)

struct XcdBarrier {
    unsigned* bar; unsigned x;
    volatile LAS unsigned* st;
};

__device__ __forceinline__ XcdBarrier xcd_barrier_post(unsigned* bar, volatile LAS unsigned* st) {
    XcdBarrier b; b.bar = bar; b.x = xb_xcc_id(); b.st = st;
    if (threadIdx.x == 0) (void)xb_add(&bar[XB_XCNT(b.x)], 1u);
    return b;
}
__device__ __forceinline__ void xcd_barrier_complete(unsigned* bar, unsigned x, unsigned& nloc, unsigned& nx) {
    const unsigned G = gridDim.x * gridDim.y * gridDim.z;
    unsigned sum, cnt, mine, sp = 0u;
    for (;;) {
        sum = 0u; cnt = 0u; mine = 0u;
#pragma unroll
        for (unsigned j = 0; j < 16; ++j) { const unsigned c = xb_ld(&bar[XB_XCNT(j)]); sum += c; cnt += (c > 0u) ? 1u : 0u; mine = (j == x) ? c : mine; }
        if (sum == G) break;
        __builtin_amdgcn_s_sleep(1);
        if ((++sp & 255u) == 0u) { if (xb_ld(&bar[XB_TMO])) break; if (sp > XB_SPIN_CAP) { atomicAdd(&bar[XB_TMO], 1u); break; } }
    }
    nloc = mine > 0u ? mine : 1u; nx = cnt > 0u ? cnt : 1u;
}

__device__ __forceinline__ void xcd_barrier(const XcdBarrier& b) {
    asm volatile("s_waitcnt vmcnt(0)" ::: "memory");
    __syncthreads();
    if (threadIdx.x == 0) {
        unsigned* bar = b.bar;
        __builtin_amdgcn_s_waitcnt(0);
        unsigned nloc = b.st[0], nx = b.st[1];
        if (nloc == 0u) { xcd_barrier_complete(bar, b.x, nloc, nx); b.st[0] = nloc; b.st[1] = nx; }
        const unsigned old = xb_add(&bar[XB_XSUB(b.x)], 1u);
        const unsigned gen = old / nloc;
        if (old + 1u == (gen + 1u) * nloc) {
            __builtin_amdgcn_fence(__ATOMIC_RELEASE, "agent");
            asm volatile("s_waitcnt vmcnt(0)" ::: "memory");
            const unsigned og = xb_add(&bar[XB_TOP], 1u);
            const unsigned tg = og / nx;
            if (og + 1u == (tg + 1u) * nx) xb_add(&bar[XB_TOPGEN], 1u);
            else XB_SPIN(xb_ld(&bar[XB_TOPGEN]) == tg, bar);
            __builtin_amdgcn_fence(__ATOMIC_ACQUIRE, "agent");
            xb_add(&bar[XB_XGEN(b.x)], 1u);
            asm volatile("s_waitcnt vmcnt(0)" ::: "memory");
        } else {
            XB_SPIN(xb_ld(&bar[XB_XGEN(b.x)]) == gen, bar);
            __builtin_amdgcn_fence(__ATOMIC_ACQUIRE, "agent");
            asm volatile("s_waitcnt vmcnt(0)" ::: "memory");
        }
    }
    __syncthreads();
}

DI void p0_mod(const float* c, const float* w_mod, const float* b_mod, float* MOD, LAS unsigned char* lds, int vcu, int G, int tid) {
    LAS float* sc = (LAS float*)lds;
    LAS float* red = (LAS float*)(lds + 32768);
    const int wave = tid >> 6, lane = tid & 63;
    for (int i = tid; i < NB * DM; i += NTHR) { const float v = c[i]; sc[i] = v / (1.f + expf(-v)); }
    __syncthreads();
    for (int task = vcu; task < 2 * (MODW / 64); task += G) {
        const int l = task / (MODW / 64), cg = task % (MODW / 64), col = cg * 64 + lane;
        const float* W = w_mod + (size_t)l * DM * MODW + col;
        float a0 = 0.f, a1 = 0.f, a2 = 0.f, a3 = 0.f;
        const int k0 = wave * 256;
#pragma unroll 16
        for (int k = 0; k < 256; ++k) {
            const float w = W[(size_t)(k0 + k) * MODW];
            a0 += w * sc[k0 + k]; a1 += w * sc[DM + k0 + k]; a2 += w * sc[2 * DM + k0 + k]; a3 += w * sc[3 * DM + k0 + k];
        }
        red[(wave * 4 + 0) * 64 + lane] = a0; red[(wave * 4 + 1) * 64 + lane] = a1; red[(wave * 4 + 2) * 64 + lane] = a2; red[(wave * 4 + 3) * 64 + lane] = a3;
        __syncthreads();
        if (tid < 256) { const int b = tid >> 6; float s = 0.f;
#pragma unroll
            for (int w = 0; w < 8; ++w) s += red[(w * 4 + b) * 64 + lane];
            MOD[(size_t)(l * NB + b) * MODW + cg * 64 + lane] = s + b_mod[l * MODW + cg * 64 + lane]; }
        __syncthreads();
    }
}
struct TrItem { const float* src; bf16* dst; int ld, K, k0, n0, drow0; };
DI void tr_load(f32x4 (&v)[8], const TrItem& I, int lane) {
    const int rr = lane >> 3, c4 = (lane & 7) * 4;
#pragma unroll
    for (int i = 0; i < 8; ++i) v[i] = *(const f32x4*)(I.src + (size_t)(I.k0 + i * 8 + rr) * I.ld + I.n0 + c4);
}
DI void tr_store(const f32x4 (&v)[8], const TrItem& I, LAS float* scr, int lane) {
    const int rr = lane >> 3, c4 = (lane & 7) * 4;
#pragma unroll
    for (int i = 0; i < 8; ++i) *(LAS f32x4*)(scr + (i * 8 + rr) * 36 + (c4 ^ (4 * i))) = v[i];
    asm volatile("" ::: "memory");
    const int c = lane & 7;
#pragma unroll
    for (int j = 0; j < 4; ++j) { const int n = (lane >> 3) + 8 * j; const LAS float* s = scr + (8 * c) * 36 + (n ^ (4 * c));
        v4u o; o.x = pk2(s[0 * 36], s[1 * 36]); o.y = pk2(s[2 * 36], s[3 * 36]); o.z = pk2(s[4 * 36], s[5 * 36]); o.w = pk2(s[6 * 36], s[7 * 36]);
        *(v4u*)(I.dst + (size_t)(I.drow0 + n) * I.K + I.k0 + 8 * c) = o; }
    asm volatile("" ::: "memory");
}
DI TrItem tr_decode(int it, const float* w_in, const float* w_out, const float* w_gate, const float* w_up, const float* w_down, bf16* WIN, bf16* WOUT, bf16* WGU, bf16* WD) {
    constexpr int I_IN = 32 * 192, I_OUT = 32 * 64, I_G = 32 * 1024, I_D = 32 * 1024;
    constexpr int PER_L = I_IN + I_OUT + 2 * I_G + I_D;
    const int l = it / PER_L; int r = it % PER_L; TrItem I;
    if (r < I_IN) { const int kb = r / 192, nb = r % 192; I.src = w_in + (size_t)l * DM * INW; I.ld = INW; I.k0 = kb * 64; I.n0 = nb * 32; I.dst = WIN + (size_t)l * NPROJ * DM; I.K = DM; I.drow0 = nb * 32; return I; } r -= I_IN;
    if (r < I_OUT) { const int kb = r / 64, nb = r % 64; I.src = w_out + (size_t)l * DM * DM; I.ld = DM; I.k0 = kb * 64; I.n0 = nb * 32; I.dst = WOUT + (size_t)l * DM * DM; I.K = DM; I.drow0 = nb * 32; return I; } r -= I_OUT;
    if (r < 2 * I_G) { const int up = r / I_G; r %= I_G; const int e = r >> 10, kb = (r >> 5) & 31, nb = r & 31, n0 = nb * 32;
        I.src = (up ? w_up : w_gate) + (size_t)(l * NEXP + e) * DM * FFE; I.ld = FFE; I.k0 = kb * 64; I.n0 = n0; I.dst = WGU + (size_t)(l * NEXP + e) * 2048 * DM; I.K = DM; I.drow0 = (n0 >> 7) * 256 + (n0 & 127) + up * 128; return I; } r -= 2 * I_G;
    { const int e = r >> 10, kb = (r >> 6) & 15, nb = r & 63;
        I.src = w_down + (size_t)(l * NEXP + e) * FFE * DM; I.ld = DM; I.k0 = kb * 64; I.n0 = nb * 32; I.dst = WD + (size_t)(l * NEXP + e) * DM * FFE; I.K = FFE; I.drow0 = nb * 32; return I; }
}
DI void p0_convert(const float* w_in, const float* w_out, const float* w_gate, const float* w_up, const float* w_down, const float* rgw, const float* rew, float* WRT, const float* rel_bias, float* BTG,
                   bf16* WIN, bf16* WOUT, bf16* WGU, bf16* WD, LAS unsigned char* lds, int vcu, int G, int tid) {
    const int wave = __builtin_amdgcn_readfirstlane(tid >> 6), lane = tid & 63;
    for (int i = vcu * NTHR + tid; i < 16 * 3 * 176; i += G * NTHR) { const int h = i / 528, q = i % 528, p = q / 176, rel = q % 176 - 32;
        BTG[i] = (rel >= 0 && rel <= 128) ? rel_bias[(int)BUCKET[p][rel] * 16 + h] * 1.4426950408889634f : 0.f; }
    for (int i = vcu * NTHR + tid; i < NLAYER * 36 * DM; i += G * NTHR) { const int l = i / (36 * DM), r = i % (36 * DM), c = r / DM, k = r % DM;
        WRT[(size_t)(l * 48 + c) * DM + k] = (c < 32) ? rew[((size_t)l * DM + k) * 32 + c] : rgw[((size_t)l * DM + k) * 4 + (c - 32)]; }
    LAS float* scr = (LAS float*)(lds + wave * 9216);
    constexpr int NITEMS = NLAYER * (32 * 192 + 32 * 64 + 3 * 32 * 1024);
    const int gw = vcu * NWAVES + wave, NGW = G * NWAVES;
    int it = gw;
    if (it >= NITEMS) return;
    f32x4 va[8], vb[8];
    TrItem Ia = tr_decode(it, w_in, w_out, w_gate, w_up, w_down, WIN, WOUT, WGU, WD), Ib = Ia;
    tr_load(va, Ia, lane);
#pragma unroll 1
    for (;;) {
        const bool hb = (it + NGW < NITEMS);
        if (hb) { Ib = tr_decode(it + NGW, w_in, w_out, w_gate, w_up, w_down, WIN, WOUT, WGU, WD); tr_load(vb, Ib, lane); }
        tr_store(va, Ia, scr, lane);
        if (!hb) break;
        it += NGW;
        const bool ha = (it + NGW < NITEMS);
        if (ha) { Ia = tr_decode(it + NGW, w_in, w_out, w_gate, w_up, w_down, WIN, WOUT, WGU, WD); tr_load(va, Ia, lane); }
        tr_store(vb, Ib, scr, lane);
        if (!ha) break;
        it += NGW;
    }
}

DI void phase_a(int mode, int l, const float* xin, bf16* XB, float* OUT, const float* MOD, const float* norm1_w, const float* w_in, const float* gate_b,
                const int* TOKD, const float* TOKW, const bf16* OROWS, bf16* H, float* GATES, LAS unsigned char* lds, int vcu, int G, int tid) {
    const int wave = tid >> 6, lane = tid & 63;
    LAS float* wgT = (LAS float*)lds;
    LAS float* nwp = (LAS float*)(lds + 65536);
    LAS float* shf = (LAS float*)(lds + 73728);
    LAS float* g2t = (LAS float*)(lds + 81920);
    const int RB = T >> (31 - __builtin_clz((unsigned)G)), m_base = vcu * RB, b = m_base >> 12;
    if (mode != 2) {
        const float* wl = w_in + (size_t)l * DM * INW + NPROJ;
        for (int i = tid; i < DM * 2; i += NTHR) { const int k = i >> 1, hf = i & 1; const f32x4 v = *(const f32x4*)(wl + (size_t)k * INW + 4 * hf);
            wgT[(4 * hf + 0) * DM + k] = v.x; wgT[(4 * hf + 1) * DM + k] = v.y; wgT[(4 * hf + 2) * DM + k] = v.z; wgT[(4 * hf + 3) * DM + k] = v.w; }
        const float* sh = MOD + (size_t)(l * NB + b) * MODW; const float* scl = sh + DM; const float* nw = norm1_w + l * DM;
        for (int i = tid; i < DM; i += NTHR) { nwp[i] = nw[i] * (1.f + scl[i]); shf[i] = sh[i]; }
    }
    if (mode != 0) { const float* g2 = MOD + (size_t)((l - 1) * NB + b) * MODW + 5 * DM; for (int i = tid; i < DM; i += NTHR) g2t[i] = g2[i]; }
    __syncthreads();
    int nd0 = 0, nd1 = 0; float nw0 = 0.f, nw1 = 0.f;
    if (mode != 0 && wave < RB) { const int m = m_base + wave; nd0 = TOKD[2 * m]; nd1 = TOKD[2 * m + 1]; nw0 = TOKW[2 * m]; nw1 = TOKW[2 * m + 1]; }
    for (int r = wave; r < RB; r += NWAVES) {
        const int m = m_base + r;
        f32x4 xv[8];
        if (mode == 0) {
#pragma unroll
            for (int j = 0; j < 8; ++j) xv[j] = *(const f32x4*)(xin + (size_t)m * DM + 256 * j + 4 * lane);
        } else {
#pragma unroll
            for (int j = 0; j < 8; ++j) { const v2u w = *(const v2u*)(XB + (size_t)m * DM + 256 * j + 4 * lane); xv[j] = (f32x4){bflo(w.x), bfhi(w.x), bflo(w.y), bfhi(w.y)}; }
        }
        if (mode != 0) {
            const int d0 = nd0, d1 = nd1; const float w0 = nw0, w1 = nw1;
            v2u oa[8], ob[8];
#pragma unroll
            for (int j = 0; j < 8; ++j) { oa[j] = *(const v2u*)(OROWS + (size_t)d0 * DM + 256 * j + 4 * lane); ob[j] = *(const v2u*)(OROWS + (size_t)d1 * DM + 256 * j + 4 * lane); }
            if (r + NWAVES < RB) { const int mn = m + NWAVES; nd0 = TOKD[2 * mn]; nd1 = TOKD[2 * mn + 1]; nw0 = TOKW[2 * mn]; nw1 = TOKW[2 * mn + 1]; }
#pragma unroll
            for (int j = 0; j < 8; ++j) {
                const f32x4 gg = *(const LAS f32x4*)(g2t + 256 * j + 4 * lane);
                xv[j].x += gg.x * (w0 * bflo(oa[j].x) + w1 * bflo(ob[j].x)); xv[j].y += gg.y * (w0 * bfhi(oa[j].x) + w1 * bfhi(ob[j].x));
                xv[j].z += gg.z * (w0 * bflo(oa[j].y) + w1 * bflo(ob[j].y)); xv[j].w += gg.w * (w0 * bfhi(oa[j].y) + w1 * bfhi(ob[j].y));
                if (mode == 2) *(f32x4*)(OUT + (size_t)m * DM + 256 * j + 4 * lane) = xv[j];
                else { v2u o; o.x = pk2(xv[j].x, xv[j].y); o.y = pk2(xv[j].z, xv[j].w); *(v2u*)(XB + (size_t)m * DM + 256 * j + 4 * lane) = o; }
            }
        }
        if (mode == 2) continue;
        float ss = 0.f;
#pragma unroll
        for (int j = 0; j < 8; ++j) ss += (xv[j].x * xv[j].x + xv[j].y * xv[j].y) + (xv[j].z * xv[j].z + xv[j].w * xv[j].w);
        const float rms = rsqrtf(wave_sum(ss) * (1.f / DM) + EPS);
        float ga[8] = {0.f, 0.f, 0.f, 0.f, 0.f, 0.f, 0.f, 0.f};
#pragma unroll
        for (int j = 0; j < 8; ++j) {
            const int k = 256 * j + 4 * lane;
            const f32x4 w = *(const LAS f32x4*)(nwp + k), s0 = *(const LAS f32x4*)(shf + k);
            f32x4 h; h.x = xv[j].x * rms * w.x + s0.x; h.y = xv[j].y * rms * w.y + s0.y; h.z = xv[j].z * rms * w.z + s0.z; h.w = xv[j].w * rms * w.w + s0.w;
            v2u o; o.x = pk2(h.x, h.y); o.y = pk2(h.z, h.w);
            *(v2u*)(H + (size_t)m * DM + k) = o;
#pragma unroll
            for (int c = 0; c < 8; ++c) { const f32x4 g = *(const LAS f32x4*)(wgT + c * DM + k); ga[c] += (h.x * g.x + h.y * g.y) + (h.z * g.z + h.w * g.w); }
            asm volatile("" ::: "memory");
        }
#pragma unroll
        for (int c = 0; c < 8; ++c) ga[c] = wave_sum(ga[c]);
        if (lane < 8) { float v = ga[0];
#pragma unroll
            for (int c = 1; c < 8; ++c) v = (lane == c) ? ga[c] : v;
            GATES[(size_t)m * 8 + lane] = v + gate_b[l * 8 + lane]; }
    }
}

DI void c0_unpack(const v4u& a, const v4u& bq, float (&v)[16]) {
    v[0] = bflo(a.x); v[1] = bfhi(a.x); v[2] = bflo(a.y); v[3] = bfhi(a.y); v[4] = bflo(a.z); v[5] = bfhi(a.z); v[6] = bflo(a.w); v[7] = bfhi(a.w);
    v[8] = bflo(bq.x); v[9] = bfhi(bq.x); v[10] = bflo(bq.y); v[11] = bfhi(bq.y); v[12] = bflo(bq.z); v[13] = bfhi(bq.z); v[14] = bflo(bq.w); v[15] = bfhi(bq.w);
}
DI void phase_c0(int l, const bf16* PROJ, bf16* QKC, bf16* KH, bf16* QN, const float* q_norm_w, const float* k_norm_w, const float* conv_w, int vcu, int G, int tid) {
    const int wave = tid >> 6, lane = tid & 63;
    const int gw = vcu * NWAVES + wave, NGW = G * NWAVES;
    const int c0 = 16 * lane;
    float cw[4][16], nwq[16], nwk[16];
#pragma unroll
    for (int j = 0; j < 4; ++j)
#pragma unroll
        for (int i = 0; i < 16; i += 4) { const f32x4 w = *(const f32x4*)(conv_w + (size_t)(l * 4 + j) * 1024 + c0 + i); cw[j][i] = w.x; cw[j][i + 1] = w.y; cw[j][i + 2] = w.z; cw[j][i + 3] = w.w; }
#pragma unroll
    for (int i = 0; i < 16; i += 4) { const f32x4 a = *(const f32x4*)(q_norm_w + l * 64 + (lane & 3) * 16 + i), bq = *(const f32x4*)(k_norm_w + l * 64 + (lane & 3) * 16 + i);
        nwq[i] = a.x; nwq[i + 1] = a.y; nwq[i + 2] = a.z; nwq[i + 3] = a.w; nwk[i] = bq.x; nwk[i + 1] = bq.y; nwk[i + 2] = bq.z; nwk[i + 3] = bq.w; }
    const float ksc = (c0 >= 512) ? 0.08838834764831845f : 1.f;
    for (int rg = gw; rg < T / 8; rg += NGW) {
        const int R0 = rg * 8;
        v4u w0a = {0u, 0u, 0u, 0u}, w0b = w0a, w1a = w0a, w1b = w0a, w2a = w0a, w2b = w0a;
        if ((R0 & (SEQ - 1)) != 0) { const bf16* p = PROJ + (size_t)(R0 - 3) * NPROJ + C_MQ + c0;
            w0a = *(const v4u*)p; w0b = *(const v4u*)(p + 8); w1a = *(const v4u*)(p + NPROJ); w1b = *(const v4u*)(p + NPROJ + 8); w2a = *(const v4u*)(p + 2 * NPROJ); w2b = *(const v4u*)(p + 2 * NPROJ + 8); }
        v4u nq0, nq1, nk0, nk1, nc0, nc1;
        { const bf16* p = PROJ + (size_t)R0 * NPROJ + 16 * lane; nq0 = *(const v4u*)p; nq1 = *(const v4u*)(p + 8); nk0 = *(const v4u*)(p + 1024); nk1 = *(const v4u*)(p + 1032);
          const bf16* pc = PROJ + (size_t)R0 * NPROJ + C_MQ + c0; nc0 = *(const v4u*)pc; nc1 = *(const v4u*)(pc + 8); }
#pragma unroll 1
        for (int i = 0; i < 8; ++i) {
            const int m = R0 + i;
            const v4u q0 = nq0, q1 = nq1, k0 = nk0, k1 = nk1, w3a = nc0, w3b = nc1;
            if (i < 7) { const bf16* p = PROJ + (size_t)(m + 1) * NPROJ + 16 * lane; nq0 = *(const v4u*)p; nq1 = *(const v4u*)(p + 8); nk0 = *(const v4u*)(p + 1024); nk1 = *(const v4u*)(p + 1032);
                const bf16* pc = PROJ + (size_t)(m + 1) * NPROJ + C_MQ + c0; nc0 = *(const v4u*)pc; nc1 = *(const v4u*)(pc + 8); }
            float v[16];
            {
                c0_unpack(q0, q1, v); float ss = 0.f;
#pragma unroll
                for (int e = 0; e < 16; ++e) ss += v[e] * v[e];
                ss += __shfl_xor(ss, 1); ss += __shfl_xor(ss, 2);
                const float r = rsqrtf(ss * (1.f / 64.f) + EPS) * (0.125f * 1.4426950408889634f);
#pragma unroll
                for (int e = 0; e < 16; ++e) v[e] = v[e] * r * nwq[e];
                v4u o0, o1; o0.x = pk2(v[0], v[1]); o0.y = pk2(v[2], v[3]); o0.z = pk2(v[4], v[5]); o0.w = pk2(v[6], v[7]); o1.x = pk2(v[8], v[9]); o1.y = pk2(v[10], v[11]); o1.z = pk2(v[12], v[13]); o1.w = pk2(v[14], v[15]);
                bf16* dstp = QN + (size_t)m * 1024 + 16 * lane; *(v4u*)dstp = o0; *(v4u*)(dstp + 8) = o1;
            }
            {
                c0_unpack(k0, k1, v); float ss = 0.f;
#pragma unroll
                for (int e = 0; e < 16; ++e) ss += v[e] * v[e];
                ss += __shfl_xor(ss, 1); ss += __shfl_xor(ss, 2);
                const float r = rsqrtf(ss * (1.f / 64.f) + EPS);
#pragma unroll
                for (int e = 0; e < 16; ++e) v[e] = v[e] * r * nwk[e];
                v4u o0, o1; o0.x = pk2(v[0], v[1]); o0.y = pk2(v[2], v[3]); o0.z = pk2(v[4], v[5]); o0.w = pk2(v[6], v[7]); o1.x = pk2(v[8], v[9]); o1.y = pk2(v[10], v[11]); o1.z = pk2(v[12], v[13]); o1.w = pk2(v[14], v[15]);
                bf16* dstp = KH + ((size_t)((m >> 12) * 16 + (lane >> 2)) * SEQ + (m & (SEQ - 1))) * 64 + (lane & 3) * 16; *(v4u*)dstp = o0; *(v4u*)(dstp + 8) = o1;
            }
            {
                float y[16], x[16];
                c0_unpack(w0a, w0b, x);
#pragma unroll
                for (int e = 0; e < 16; ++e) y[e] = cw[0][e] * x[e];
                c0_unpack(w1a, w1b, x);
#pragma unroll
                for (int e = 0; e < 16; ++e) y[e] += cw[1][e] * x[e];
                c0_unpack(w2a, w2b, x);
#pragma unroll
                for (int e = 0; e < 16; ++e) y[e] += cw[2][e] * x[e];
                c0_unpack(w3a, w3b, x);
#pragma unroll
                for (int e = 0; e < 16; ++e) y[e] = siluf_(y[e] + cw[3][e] * x[e]) * ksc;
                v4u o0, o1; o0.x = pk2(y[0], y[1]); o0.y = pk2(y[2], y[3]); o0.z = pk2(y[4], y[5]); o0.w = pk2(y[6], y[7]); o1.x = pk2(y[8], y[9]); o1.y = pk2(y[10], y[11]); o1.z = pk2(y[12], y[13]); o1.w = pk2(y[14], y[15]);
                bf16* qd = QKC + (size_t)m * 1024 + c0; *(v4u*)qd = o0; *(v4u*)(qd + 8) = o1;
                w0a = w1a; w0b = w1b; w1a = w2a; w1b = w2b; w2a = w3a; w2b = w3b;
            }
        }
    }
}

DI void phase_d(const float* CG, const float* CM, float* MS, const float* __restrict__ CL, bf16* __restrict__ CS, const float* NLOC, float* NS, LAS unsigned char* lds, int vcu, int G, int tid) {
    LAS float* dec = (LAS float*)lds;
    LAS float* inj = dec + 512;
    dec[tid] = CG[tid]; inj[tid] = CM[tid];
    __syncthreads();
    if (tid < 16) { float m = 0.f;
#pragma unroll 1
        for (int c = 0; c < 32; ++c) { const int u = tid * 32 + c; const float gg = dec[u], ml = inj[u]; const float mn = fmaxf(gg + m, ml);
            dec[u] = expf(gg + m - mn); inj[u] = expf(ml - mn); if (vcu == 0) MS[u] = m; m = mn; } }
    __syncthreads();
    for (int v = vcu * NTHR + tid; v < 16 * 8192; v += G * NTHR) {
        const int bh = v >> 13, i4 = (v & 8191) * 4;
        f32x4 C = {0.f, 0.f, 0.f, 0.f};
#pragma unroll 1
        for (int c0 = 0; c0 < 32; c0 += 8) {
            f32x4 cl[8];
#pragma unroll
            for (int c = 0; c < 8; ++c) cl[c] = *(const f32x4*)(CL + (size_t)(bh * 32 + c0 + c) * 32768 + i4);
#pragma unroll
            for (int c = 0; c < 8; ++c) { const int u = bh * 32 + c0 + c; v2u o; o.x = pk2(C.x, C.y); o.y = pk2(C.z, C.w);
                *(v2u*)(CS + (size_t)u * 32768 + i4) = o; const float d = dec[u], ij = inj[u]; C = C * d + cl[c] * ij; }
        }
    }
    if (vcu == (G > 1 ? 1 : 0)) {
        for (int e = tid; e < 16 * 128; e += NTHR) { const int bh = e >> 7, dk = e & 127; float n = 0.f;
#pragma unroll 4
            for (int c = 0; c < 32; ++c) { const int u = bh * 32 + c; NS[u * 128 + dk] = n; n = dec[u] * n + inj[u] * NLOC[u * 128 + dk]; } }
    }
}

typedef float f32x4m __attribute__((ext_vector_type(4)));
DI void phase_g(int l, const bf16* X, const float* MOD, const float* norm2_w, const float* wg, const float* bg, const float* we, const float* be, const float* WRT,
                bf16* H, int* TOKE, float* TOKW, int* TOKR, int* HIST, LAS unsigned char* lds, int vcu, int G, int tid) {
    const int wave = __builtin_amdgcn_readfirstlane(tid >> 6), lane = tid & 63;
    LAS float* nwp = (LAS float*)lds;
    LAS float* shf = (LAS float*)(lds + 8192);
    LAS float* part = (LAS float*)(lds + 16384);
    LAS float* ssqp = (LAS float*)(lds + 40960);
    LAS float* biasp = (LAS float*)(lds + 43008);
    LAS float* rmsv = (LAS float*)(lds + 43264);
    LAS float* red = (LAS float*)(lds + 43520);
    LAS int* esel = (LAS int*)(lds + 44800);
    for (int round = vcu; round < T / 64; round += G) {
        const int m0 = round * 64, b = m0 >> 12;
        const float* sh2 = MOD + (size_t)(l * NB + b) * MODW + 3 * DM; const float* sc2 = sh2 + DM;
        for (int i = tid; i < DM; i += NTHR) { nwp[i] = norm2_w[l * DM + i] * (1.f + sc2[i]); shf[i] = sh2[i]; }
        __syncthreads();
        {
            float pb[36];
#pragma unroll
            for (int c = 0; c < 36; ++c) pb[c] = 0.f;
#pragma unroll
            for (int i = 0; i < 4; ++i) { const int k = tid + NTHR * i; const float s = shf[k];
#pragma unroll
                for (int q = 0; q < 8; ++q) { const f32x4 w = *(const f32x4*)(we + (size_t)k * 32 + 4 * q); pb[4 * q] += s * w.x; pb[4 * q + 1] += s * w.y; pb[4 * q + 2] += s * w.z; pb[4 * q + 3] += s * w.w; }
                const f32x4 w = *(const f32x4*)(wg + (size_t)k * 4); pb[32] += s * w.x; pb[33] += s * w.y; pb[34] += s * w.z; pb[35] += s * w.w; }
#pragma unroll
            for (int c = 0; c < 36; ++c) { const float v = wave_sum(pb[c]); if (lane == 0) red[wave * 36 + c] = v; }
            __syncthreads();
            if (tid < 36) { float s = 0.f;
#pragma unroll
                for (int w = 0; w < 8; ++w) s += red[w * 36 + tid];
                biasp[tid] = s + (tid < 32 ? be[tid] : bg[tid - 32]); }
        }
        {
            const int rt = wave & 3, kh = wave >> 2, row = lane & 15, kq = lane >> 4, col = lane & 15;
            const bf16* xr = X + (size_t)(m0 + 16 * rt + row) * DM + kh * 1024 + 4 * kq;
            const float* w0p = WRT + (size_t)(l * 48 + col) * DM + kh * 1024 + 4 * kq;
            const float* w1p = w0p + (size_t)16 * DM; const float* w2p = WRT + (size_t)(l * 48 + 32 + (col & 3)) * DM + kh * 1024 + 4 * kq;
            const LAS float* nwq = nwp + kh * 1024 + 4 * kq;
            f32x4 a0 = {0.f, 0.f, 0.f, 0.f}, a1 = a0, a2 = a0; float ssq = 0.f;
#pragma unroll 8
            for (int jj = 0; jj < 64; ++jj) {
                const v2u xw = *(const v2u*)(xr + 16 * jj); const f32x4 xv = {bflo(xw.x), bfhi(xw.x), bflo(xw.y), bfhi(xw.y)};
                const f32x4 nw = *(const LAS f32x4*)(nwq + 16 * jj);
                f32x4 b0 = *(const f32x4*)(w0p + 16 * jj), b1 = *(const f32x4*)(w1p + 16 * jj), b2 = *(const f32x4*)(w2p + 16 * jj);
                if (col >= 4) b2 = (f32x4){0.f, 0.f, 0.f, 0.f};
                ssq += (xv.x * xv.x + xv.y * xv.y) + (xv.z * xv.z + xv.w * xv.w);
                b0 = b0 * nw; b1 = b1 * nw; b2 = b2 * nw;
#pragma unroll
                for (int e = 0; e < 4; ++e) {
                    a0 = __builtin_amdgcn_mfma_f32_16x16x4f32(xv[e], b0[e], a0, 0, 0, 0);
                    a1 = __builtin_amdgcn_mfma_f32_16x16x4f32(xv[e], b1[e], a1, 0, 0, 0);
                    a2 = __builtin_amdgcn_mfma_f32_16x16x4f32(xv[e], b2[e], a2, 0, 0, 0); }
            }
#pragma unroll
            for (int r = 0; r < 4; ++r) { LAS float* p = part + ((kh * 64 + 16 * rt + 4 * kq + r) * 48); p[col] = a0[r]; p[16 + col] = a1[r]; p[32 + col] = a2[r]; }
            ssqp[(kh * 64 + 16 * rt + row) * 4 + kq] = ssq;
        }
        __syncthreads();
        if (tid < 64) { float ss = 0.f;
#pragma unroll
            for (int i = 0; i < 4; ++i) ss += ssqp[tid * 4 + i] + ssqp[(64 + tid) * 4 + i];
            rmsv[tid] = rsqrtf(ss * (1.f / DM) + EPS); }
        __syncthreads();
        if (wave == 0) {
            const int r = lane, m = m0 + r;
            const float rms = rmsv[r];
            const LAS float* p0 = part + r * 48; const LAS float* p1 = part + (64 + r) * 48;
            float lg[4];
#pragma unroll
            for (int j = 0; j < 4; ++j) lg[j] = rms * (p0[32 + j] + p1[32 + j]) + biasp[32 + j];
            int gs = 0; float gm = lg[0];
#pragma unroll
            for (int j = 1; j < 4; ++j) if (lg[j] > gm) { gm = lg[j]; gs = j; }
            float den = 0.f;
#pragma unroll
            for (int j = 0; j < 4; ++j) den += expf(lg[j] - gm);
            const float pg = 1.f / den;
            float v0 = -3.0e38f, v1 = -3.0e38f; int i0 = 0, i1 = 0;
#pragma unroll 1
            for (int i = 0; i < 8; ++i) { const int c = gs * 8 + i; const float v = rms * (p0[c] + p1[c]) + biasp[c];
                if (v > v0) { v1 = v0; i1 = i0; v0 = v; i0 = i; } else if (v > v1) { v1 = v; i1 = i; } }
            const float t = expf(v1 - v0), w0 = pg / (1.f + t), w1 = pg * t / (1.f + t);
            const int e0 = gs * 8 + i0, e1 = gs * 8 + i1;
            esel[2 * r] = e0; esel[2 * r + 1] = e1;
            TOKE[2 * m] = e0; TOKE[2 * m + 1] = e1; TOKW[2 * m] = w0; TOKW[2 * m + 1] = w1;
            LDS_WAIT(); asm volatile("" ::: "memory");
            int r0 = 0, r1 = 0;
#pragma unroll 2
            for (int q = 0; q < r; ++q) { const int a = esel[2 * q], c = esel[2 * q + 1]; r0 += (a == e0) + (c == e0); r1 += (a == e1) + (c == e1); }
            TOKR[2 * m] = r0; TOKR[2 * m + 1] = r1;
            if (lane < 32) { int n = 0;
#pragma unroll 8
                for (int q = 0; q < 128; ++q) n += (esel[q] == lane);
                HIST[round * 32 + lane] = n; }
        } else {
#pragma unroll 1
            for (int r = wave - 1; r < 64; r += 14) { const int r2 = (r + 7 < 64) ? r + 7 : r; const int m = m0 + r, m2 = m0 + r2; const float rms0 = rmsv[r], rms1 = rmsv[r2];
                f32x4 xa[8], xb[8];
#pragma unroll
                for (int j = 0; j < 8; ++j) { const v2u wa = *(const v2u*)(X + (size_t)m * DM + 256 * j + 4 * lane), wb = *(const v2u*)(X + (size_t)m2 * DM + 256 * j + 4 * lane);
                    xa[j] = (f32x4){bflo(wa.x), bfhi(wa.x), bflo(wa.y), bfhi(wa.y)}; xb[j] = (f32x4){bflo(wb.x), bfhi(wb.x), bflo(wb.y), bfhi(wb.y)}; }
#pragma unroll
                for (int j = 0; j < 8; ++j) { const int k = 256 * j + 4 * lane;
                    const f32x4 nw = *(const LAS f32x4*)(nwp + k), s0 = *(const LAS f32x4*)(shf + k);
                    v2u o; o.x = pk2(xa[j].x * rms0 * nw.x + s0.x, xa[j].y * rms0 * nw.y + s0.y); o.y = pk2(xa[j].z * rms0 * nw.z + s0.z, xa[j].w * rms0 * nw.w + s0.w);
                    *(v2u*)(H + (size_t)m * DM + k) = o;
                    o.x = pk2(xb[j].x * rms1 * nw.x + s0.x, xb[j].y * rms1 * nw.y + s0.y); o.y = pk2(xb[j].z * rms1 * nw.z + s0.z, xb[j].w * rms1 * nw.w + s0.w);
                    *(v2u*)(H + (size_t)m2 * DM + k) = o; } }
        }
        __syncthreads();
    }
}

DI void phase_h0(const int* HIST, const int* TOKE, const int* TOKR, int* TOKD, int* ROWTOK, int* TILE, LAS unsigned char* lds, int vcu, int G, int tid) {
    LAS int* pre = (LAS int*)lds;
    LAS int* cnt = pre + 8192;
    LAS int* rowstart = cnt + 32;
    for (int i = tid; i < 8192; i += NTHR) pre[i] = HIST[i];
    __syncthreads();
    {
        LAS int* seg = rowstart + 32;
        const int e = tid & 31, sg = tid >> 5; int run = 0;
#pragma unroll
        for (int r = 0; r < 16; ++r) { const int idx = (sg * 16 + r) * 32 + e; const int t = pre[idx]; pre[idx] = run; run += t; }
        seg[sg * 32 + e] = run;
        __syncthreads();
        if (tid < 32) { int acc = 0;
#pragma unroll
            for (int s = 0; s < 16; ++s) { const int t = seg[s * 32 + tid]; seg[s * 32 + tid] = acc; acc += t; }
            cnt[tid] = acc; }
        __syncthreads();
        const int off = seg[sg * 32 + e];
#pragma unroll
        for (int r = 0; r < 16; ++r) pre[(sg * 16 + r) * 32 + e] += off;
    }
    __syncthreads();
    if (tid == 0) { int ts = 0;
#pragma unroll 1
        for (int e = 0; e < 32; ++e) { rowstart[e] = ts * 256; const int nt = (cnt[e] + 255) >> 8;
            if (vcu == 0) {
#pragma unroll 1
                for (int i = 0; i < nt; ++i) TILE[1 + ts + i] = e; }
            ts += nt; }
        if (vcu == 0) TILE[0] = ts; }
    __syncthreads();
    if (vcu < 32) {
        const int e = vcu, nt = (cnt[e] + 255) >> 8;
        for (int i = cnt[e] + tid; i < nt * 256; i += NTHR) ROWTOK[rowstart[e] + i] = 0;
    }
    for (int m = vcu * NTHR + tid; m < T; m += G * NTHR) {
        const int e0 = TOKE[2 * m], e1 = TOKE[2 * m + 1], round = m >> 6;
        const int d0 = rowstart[e0] + pre[round * 32 + e0] + TOKR[2 * m], d1 = rowstart[e1] + pre[round * 32 + e1] + TOKR[2 * m + 1];
        TOKD[2 * m] = d0; TOKD[2 * m + 1] = d1; ROWTOK[d0] = m; ROWTOK[d1] = m;
    }
}

constexpr int AT_OACC = 0, AT_ML = 69632, AT_BT = 71680, AT_VB = 73984, AT_VBW = 4608, AT_BTS = 176;
constexpr float LOG2E = 1.4426950408889634f;
DI void at_softmax(f32x4 (&s)[9], int p, int qs0, int li, int g, const LAS float* BT, float& mx, float& lsum) {
    int lbr = li - 4 * g + 128; asm volatile("" : "+v"(lbr));
    const int kb0 = qs0 - 128 + 4 * g;
    const LAS float* btp = BT + p * AT_BTS + (lbr - 116);
    mx = -1.0e30f;
    if (qs0 >= 128) {
#pragma unroll
        for (int kt = 0; kt < 9; ++kt)
#pragma unroll
            for (int e = 0; e < 4; ++e) { const int c = 16 * kt + e, rel = lbr - c;
                float v = s[kt][e] + btp[148 - c];
                if (kt == 0) v = (rel <= 128) ? v : -1.0e30f;
                if (kt == 8) v = (rel >= 0) ? v : -1.0e30f;
                s[kt][e] = v; mx = fmaxf(mx, v); }
    } else {
#pragma unroll
        for (int kt = 0; kt < 9; ++kt)
#pragma unroll
            for (int e = 0; e < 4; ++e) { const int c = 16 * kt + e, rel = lbr - c;
                const bool valid = (rel >= 0) && (rel <= 128) && (kb0 + c >= 0);
                const float v = valid ? s[kt][e] + btp[148 - c] : -1.0e30f;
                s[kt][e] = v; mx = fmaxf(mx, v); }
    }
    mx = fmaxf(mx, __shfl_xor(mx, 16)); mx = fmaxf(mx, __shfl_xor(mx, 32));
    lsum = 0.f;
#pragma unroll
    for (int kt = 0; kt < 9; ++kt)
#pragma unroll
        for (int e = 0; e < 4; ++e) { const float pv = __builtin_amdgcn_exp2f(s[kt][e] - mx); s[kt][e] = pv; lsum += pv; }
    lsum += __shfl_xor(lsum, 16); lsum += __shfl_xor(lsum, 32);
}
DI bf16x8 at_pack(const f32x4& a, const f32x4& b) { v4u w; w.x = pk2(a[0], a[1]); w.y = pk2(a[2], a[3]); w.z = pk2(b[0], b[1]); w.w = pk2(b[2], b[3]); return __builtin_bit_cast(bf16x8, w); }
DI void at_merge(const f32x4 (&acc)[4], float mx, float lsum, int tau, int g, bool first, LAS float* OACC, LAS float* MLs) {
    LAS float* orow = OACC + tau * 68 + 4 * g;
    if (first) {
#pragma unroll
        for (int dt = 0; dt < 4; ++dt) *(LAS f32x4*)(orow + 16 * dt) = acc[dt];
        if (g == 0) { MLs[2 * tau] = mx; MLs[2 * tau + 1] = lsum; }
    } else {
        const float M0 = MLs[2 * tau], L0 = MLs[2 * tau + 1];
        const float Mn = fmaxf(M0, mx), c0 = __builtin_amdgcn_exp2f(M0 - Mn), c1 = __builtin_amdgcn_exp2f(mx - Mn);
#pragma unroll
        for (int dt = 0; dt < 4; ++dt) { const f32x4 o = *(const LAS f32x4*)(orow + 16 * dt); *(LAS f32x4*)(orow + 16 * dt) = o * c0 + acc[dt] * c1; }
        LDS_WAIT();
        if (g == 0) { MLs[2 * tau] = Mn; MLs[2 * tau + 1] = L0 * c0 + lsum * c1; }
    }
}
template <int MODE> DI void attn_unit(int b, int h, int tt, const bf16* QN, const bf16* KH, const bf16* VH, bf16* MIXED, const float* rel_bias, LAS unsigned char* lds, int tid) {
    const int wave = __builtin_amdgcn_readfirstlane(tid >> 6), lane = tid & 63, g = lane >> 4, li = lane & 15;
    LAS float* OACC = (LAS float*)(lds + AT_OACC);
    LAS float* MLs = (LAS float*)(lds + AT_ML);
    LAS float* BT = (LAS float*)(lds + AT_BT);
    LAS bf16* VB = (LAS bf16*)(lds + AT_VB + wave * AT_VBW);
    for (int i = tid; i < 3 * AT_BTS; i += NTHR) BT[i] = rel_bias[h * (3 * AT_BTS) + i];
    __syncthreads();
    const size_t rowbase = (size_t)b * SEQ;
    const int t0 = tt * 256;
    const char* qbase = (const char*)(QN + rowbase * 1024 + h * 64);
    const char* kbase = (const char*)(KH + (size_t)(b * 16 + h) * SEQ * 64); const char* vbase = (const char*)(VH + (size_t)(b * 16 + h) * SEQ * 64);
    LAS bf16* wdst = VB + (lane >> 3) * 72 + (lane & 7) * 8;
    const LAS bf16* kfrag = VB + li * 72 + 8 * g;
    const LAS bf16* vfrag = VB + (4 * g + (li >> 2)) * 72 + 4 * (li & 3);
#ifndef AT_PAIR
#define AT_PAIR 0
#endif
#if AT_PAIR
#pragma unroll 1
    for (int p = 0; p < 2; ++p) {
        if (!((AT_PAIR >> p) & 1)) continue;
        const int sh = 2 * p, j = 2 * wave;
        const int r = (p == 0) ? 0 : (j >> 2), sb = (p == 0) ? j : (j & 3);
        const int qs0 = (t0 >> sh) + 16 * sb;
        const int tqa = ((qs0 + li) << sh) + r, tqb = ((qs0 + 16 + li) << sh) + r;
        bf16x8 qa0, qa1, qb0, qb1; v4u kr[20], vr[20];
        {   const unsigned qo = (unsigned)(tqa * 1024 + 8 * g) * 2u, qo2 = (unsigned)(tqb * 1024 + 8 * g) * 2u;
            qa0 = *(const bf16x8*)(qbase + qo); qa1 = *(const bf16x8*)(qbase + qo + 64); qb0 = *(const bf16x8*)(qbase + qo2); qb1 = *(const bf16x8*)(qbase + qo2 + 64);
#pragma unroll
            for (int i = 0; i < 20; ++i) { const int ks = min(max(qs0 - 128 + 8 * i + (lane >> 3), 0), qs0 + 31); const unsigned o = (unsigned)(((ks << sh) + r) * 64 + (lane & 7) * 8) * 2u;
                kr[i] = *(const v4u*)(kbase + o); vr[i] = *(const v4u*)(vbase + o); } }
        f32x4 sa[9], sb_[9];
#pragma unroll
        for (int c = 0; c < 5; ++c) {
#pragma unroll
            for (int i = 0; i < 4; ++i) *(LAS v4u*)(wdst + 8 * i * 72) = kr[4 * c + i];
            asm volatile("" ::: "memory");
#pragma unroll
            for (int t2 = 0; t2 < 2; ++t2) { const int t = 2 * c + t2; const bf16x8 k0 = *(const LAS bf16x8*)(kfrag + 16 * t2 * 72), k1 = *(const LAS bf16x8*)(kfrag + 16 * t2 * 72 + 32);
                if (t < 9) { f32x4 z = {0.f, 0.f, 0.f, 0.f}; z = MFMA16(k0, qa0, z); sa[t] = MFMA16(k1, qa1, z); }
                if (t >= 1) { f32x4 z = {0.f, 0.f, 0.f, 0.f}; z = MFMA16(k0, qb0, z); sb_[t - 1] = MFMA16(k1, qb1, z); } }
            asm volatile("" ::: "memory");
        }
        float mxa, lsa, mxb, lsb;
        at_softmax(sa, p, qs0, li, g, BT, mxa, lsa);
        at_softmax(sb_, p, qs0 + 16, li, g, BT, mxb, lsb);
        f32x4 acca[4], accb[4];
#pragma unroll
        for (int dt = 0; dt < 4; ++dt) { acca[dt] = (f32x4){0.f, 0.f, 0.f, 0.f}; accb[dt] = acca[dt]; }
        const f32x4 zero4 = {0.f, 0.f, 0.f, 0.f};
#pragma unroll
        for (int s2 = 0; s2 < 5; ++s2) {
#pragma unroll
            for (int i = 0; i < 4; ++i) *(LAS v4u*)(wdst + 8 * i * 72) = vr[4 * s2 + i];
            asm volatile("" ::: "memory");
            const bf16x8 pa = at_pack(sa[2 * s2], (s2 < 4) ? sa[2 * s2 + 1] : zero4);
            const bf16x8 pb = at_pack((s2 > 0) ? sb_[2 * s2 - 1] : zero4, sb_[2 * s2]);
#pragma unroll
            for (int dt = 0; dt < 4; ++dt) { const bf16x8 vf = mk8(tr_read(vfrag + 16 * dt), tr_read(vfrag + 16 * dt + 16 * 72));
                acca[dt] = MFMA16(vf, pa, acca[dt]); accb[dt] = MFMA16(vf, pb, accb[dt]); }
            asm volatile("" ::: "memory");
        }
        at_merge(acca, mxa, lsa, tqa - t0, g, p == 0, OACC, MLs);
        at_merge(accb, mxb, lsb, tqb - t0, g, p == 0, OACC, MLs);
        __syncthreads();
    }
#endif
#pragma unroll 1
    for (int gi = 0; gi < 6; ++gi) {
        if (gi < 4 && ((AT_PAIR >> (gi >> 1)) & 1)) continue;
        const int p = gi >> 1, jj = gi & 1, sh = 2 * p, j = 2 * wave + jj;
        const int r = (p == 0) ? 0 : (p == 1 ? (j >> 2) : j), sbx = (p == 0) ? j : (p == 1 ? (j & 3) : 0), qs0 = (t0 >> sh) + 16 * sbx;
        const int tq = ((qs0 + li) << sh) + r;
        bf16x8 qf0, qf1; v4u kr[18], vr[20];
        {   const unsigned qo = (unsigned)(tq * 1024 + 8 * g) * 2u; qf0 = *(const bf16x8*)(qbase + qo); qf1 = *(const bf16x8*)(qbase + qo + 64);
#pragma unroll
            for (int i = 0; i < 20; ++i) { const int ks = min(max(qs0 - 128 + 8 * i + (lane >> 3), 0), qs0 + 15); const unsigned o = (unsigned)(((ks << sh) + r) * 64 + (lane & 7) * 8) * 2u;
                if (i < 18) kr[i] = *(const v4u*)(kbase + o);
                vr[i] = *(const v4u*)(vbase + o); } }
        f32x4 s[9];
#pragma unroll
        for (int c = 0; c < 5; ++c) {
#pragma unroll
            for (int i = 0; i < 4; ++i) if (4 * c + i < 18) *(LAS v4u*)(wdst + 8 * i * 72) = kr[4 * c + i];
            asm volatile("" ::: "memory");
#pragma unroll
            for (int t2 = 0; t2 < 2; ++t2) { const int t = 2 * c + t2; if (t < 9) { f32x4 z = {0.f, 0.f, 0.f, 0.f};
                z = MFMA16(*(const LAS bf16x8*)(kfrag + 16 * t2 * 72), qf0, z); s[t] = MFMA16(*(const LAS bf16x8*)(kfrag + 16 * t2 * 72 + 32), qf1, z); } }
            asm volatile("" ::: "memory");
        }
        float mx, lsum;
        at_softmax(s, p, qs0, li, g, BT, mx, lsum);
        f32x4 acc[4];
#pragma unroll
        for (int dt = 0; dt < 4; ++dt) acc[dt] = (f32x4){0.f, 0.f, 0.f, 0.f};
        const f32x4 zero4 = {0.f, 0.f, 0.f, 0.f};
#pragma unroll
        for (int s2 = 0; s2 < 5; ++s2) {
#pragma unroll
            for (int i = 0; i < 4; ++i) *(LAS v4u*)(wdst + 8 * i * 72) = vr[4 * s2 + i];
            asm volatile("" ::: "memory");
            const bf16x8 pf = at_pack(s[2 * s2], (s2 < 4) ? s[2 * s2 + 1] : zero4);
#pragma unroll
            for (int dt = 0; dt < 4; ++dt) acc[dt] = MFMA16(mk8(tr_read(vfrag + 16 * dt), tr_read(vfrag + 16 * dt + 16 * 72)), pf, acc[dt]);
            asm volatile("" ::: "memory");
        }
        at_merge(acc, mx, lsum, tq - t0, g, p == 0, OACC, MLs);
        if (jj == 1) __syncthreads();
    }
    __syncthreads();
    {
        const int tau = tid >> 1, hf = tid & 1;
        const float inv = 1.f / MLs[2 * tau + 1];
        const LAS float* o = OACC + tau * 68 + hf * 32;
        bf16* dst = MIXED + (rowbase + t0 + tau) * DM + h * 64 + hf * 32;
#pragma unroll
        for (int i = 0; i < 4; ++i) { const f32x4 a = *(const LAS f32x4*)(o + 8 * i), c = *(const LAS f32x4*)(o + 8 * i + 4);
            v4u w; w.x = pk2(a.x * inv, a.y * inv); w.y = pk2(a.z * inv, a.w * inv); w.z = pk2(c.x * inv, c.y * inv); w.w = pk2(c.z * inv, c.w * inv);
            *(v4u*)(dst + 8 * i) = w; }
    }
    __syncthreads();
}

constexpr int ML_SC = 0, ML_KW = 4096, ML_VS = 4096 + 128 * 136 * 2;
DI void mlstm_local_unit(int u, const bf16* PROJ, const bf16* QKC, const float* GATES, float* BCUM, float* CG, float* CM, float* CL, float* NLOC, LAS unsigned char* lds, int tid) {
    const int wave = __builtin_amdgcn_readfirstlane(tid >> 6), lane = tid & 63, g = lane >> 4, li = lane & 15;
    const int b = u >> 7, hh = (u >> 5) & 3, c = u & 31, m0 = b * SEQ + c * 128;
    LAS float* sc = (LAS float*)(lds + ML_SC);
    LAS bf16* Kw = (LAS bf16*)(lds + ML_KW);
    LAS bf16* Vs = (LAS bf16*)(lds + ML_VS);
    v4u rk[4], rv[8];
#pragma unroll
    for (int i = 0; i < 4; ++i) { const int id = tid + NTHR * i; rk[i] = *(const v4u*)(QKC + (size_t)(m0 + (id >> 4)) * 1024 + 512 + hh * 128 + (id & 15) * 8); }
#pragma unroll
    for (int i = 0; i < 8; ++i) { const int id = tid + NTHR * i; rv[i] = *(const v4u*)(PROJ + (size_t)(m0 + (id >> 5)) * NPROJ + C_MV + hh * 256 + (id & 31) * 8); }
    float ip = 0.f, bc = 0.f;
    if (tid < 128) {
        ip = GATES[(size_t)(m0 + tid) * 8 + hh]; const float fp = GATES[(size_t)(m0 + tid) * 8 + 4 + hh];
        float v = logsigmoidf_(fp);
#pragma unroll
        for (int o = 1; o < 64; o <<= 1) { const float t = __shfl_up(v, o); if (lane >= o) v += t; }
        bc = v;
        if (tid == 63) sc[384] = v;
    }
    __syncthreads();
    if (tid < 128) { if (tid >= 64) bc += sc[384]; sc[tid] = bc; BCUM[(size_t)(m0 + tid) * 4 + hh] = bc; }
    __syncthreads();
    if (tid < 128) { const float gs = sc[127]; const float a = gs - bc + ip; sc[128 + tid] = a; const float wm = wave_max(a); if (lane == 0) sc[385 + wave] = wm; }
    __syncthreads();
    const float mloc = fmaxf(sc[385], sc[386]);
    if (tid < 128) sc[256 + tid] = expf(sc[128 + tid] - mloc);
    if (tid == 0) { CG[u] = sc[127]; CM[u] = mloc; }
    __syncthreads();
#pragma unroll
    for (int i = 0; i < 4; ++i) { const int id = tid + NTHR * i, row = id >> 4, ch = id & 15; const float w = sc[256 + row]; const v4u a = rk[i];
        v4u o; o.x = pk2(bflo(a.x) * w, bfhi(a.x) * w); o.y = pk2(bflo(a.y) * w, bfhi(a.y) * w); o.z = pk2(bflo(a.z) * w, bfhi(a.z) * w); o.w = pk2(bflo(a.w) * w, bfhi(a.w) * w);
        *(LAS v4u*)(Kw + row * 136 + ch * 8) = o; }
#pragma unroll
    for (int i = 0; i < 8; ++i) { const int id = tid + NTHR * i, row = id >> 5, ch = id & 31; *(LAS v4u*)(Vs + row * 264 + ch * 8) = rv[i]; }
    __syncthreads();
    f32x4 acc[2][8];
#pragma unroll
    for (int vi = 0; vi < 2; ++vi)
#pragma unroll
        for (int kt = 0; kt < 8; ++kt) acc[vi][kt] = (f32x4){0.f, 0.f, 0.f, 0.f};
#pragma unroll
    for (int s4 = 0; s4 < 4; ++s4) {
        const int rbase = 32 * s4 + 8 * g + (li >> 2), cofs = 4 * (li & 3);
        bf16x8 af[2];
#pragma unroll
        for (int vi = 0; vi < 2; ++vi) { const LAS bf16* p = Vs + rbase * 264 + 16 * (2 * wave + vi) + cofs; af[vi] = mk8(tr_read(p), tr_read(p + 4 * 264)); }
#pragma unroll
        for (int kt = 0; kt < 8; ++kt) { const LAS bf16* p = Kw + rbase * 136 + 16 * kt + cofs; const bf16x8 bfr = mk8(tr_read(p), tr_read(p + 4 * 136));
            acc[0][kt] = MFMA16(af[0], bfr, acc[0][kt]); acc[1][kt] = MFMA16(af[1], bfr, acc[1][kt]); }
    }
    float* out = CL + (size_t)u * 32768;
#pragma unroll
    for (int vi = 0; vi < 2; ++vi)
#pragma unroll
        for (int kt = 0; kt < 8; ++kt)
#pragma unroll
            for (int e = 0; e < 4; ++e) out[(size_t)(16 * (2 * wave + vi) + 4 * g + e) * 128 + 16 * kt + li] = acc[vi][kt][e];
    {
        const int dk = tid & 127, part = tid >> 7; float n = 0.f;
#pragma unroll 8
        for (int s = 0; s < 32; ++s) n += bf2f((unsigned)Kw[(32 * part + s) * 136 + dk]);
        sc[512 + tid] = n;
        __syncthreads();
        if (tid < 128) NLOC[(size_t)u * 128 + tid] = (sc[512 + tid] + sc[640 + tid]) + (sc[768 + tid] + sc[896 + tid]);
    }
    __syncthreads();
}

constexpr int MO_VS = 0, MO_SC = 128 * 264 * 2, MO_CS = MO_SC + 4096;
static_assert(MO_CS + 256 * 136 * 2 <= LDS_PERSIST, "mLSTM-out LDS map");
DI void mlstm_out_unit(int l, int u, const bf16* PROJ, const bf16* QKC, const float* GATES, const float* BCUM, const float* MS, const bf16* CS, const float* NS,
                       const float* h_norm_w, bf16* MIXED, LAS unsigned char* lds, int tid) {
    const int wave = __builtin_amdgcn_readfirstlane(tid >> 6), lane = tid & 63, g = lane >> 4, li = lane & 15;
    const int b = u >> 7, hh = (u >> 5) & 3, c = u & 31, m0 = b * SEQ + c * 128;
    LAS bf16* Vs = (LAS bf16*)(lds + MO_VS);
    LAS float* sc = (LAS float*)(lds + MO_SC);
    const float ms = MS[u];
    float us = 0.f, pm = 0.f, bq = 0.f;
    if (tid < 128) {
        bq = BCUM[(size_t)(m0 + tid) * 4 + hh]; us = GATES[(size_t)(m0 + tid) * 8 + hh] - bq;
        float v = us;
#pragma unroll
        for (int o = 1; o < 64; o <<= 1) { const float t = __shfl_up(v, o); if (lane >= o) v = fmaxf(v, t); }
        pm = v;
        if (tid == 63) sc[512] = v;
        sc[384 + tid] = NS[(size_t)u * 128 + tid];
    }
    __syncthreads();
    if (tid < 128) { if (tid >= 64) pm = fmaxf(pm, sc[512]); sc[tid] = us; sc[128 + tid] = fmaxf(ms, pm); sc[256 + tid] = bq; }
    LAS bf16* Cs = (LAS bf16*)(lds + MO_CS);
    {
        v4u tv[8], tc[8];
#pragma unroll
        for (int i = 0; i < 8; ++i) { const int id = tid + NTHR * i; tv[i] = *(const v4u*)(PROJ + (size_t)(m0 + (id >> 5)) * NPROJ + C_MV + hh * 256 + (id & 31) * 8);
            tc[i] = *(const v4u*)(CS + (size_t)u * 32768 + (size_t)id * 8); }
#pragma unroll
        for (int i = 0; i < 8; ++i) { const int id = tid + NTHR * i; *(LAS v4u*)(Vs + (id >> 5) * 264 + (id & 31) * 8) = tv[i]; *(LAS v4u*)(Cs + (id >> 4) * 136 + (id & 15) * 8) = tc[i]; }
    }
    __syncthreads();
    const int q = 16 * wave + li;
    const float Mq = sc[128 + q], einter = expf(ms - Mq);
    bf16x8 qf[4], qs[4]; float qd = 0.f;
    { const bf16* qp = QKC + (size_t)(m0 + q) * 1024 + hh * 128 + 8 * g;
#pragma unroll
      for (int ks = 0; ks < 4; ++ks) { const v4u a = *(const v4u*)(qp + 32 * ks); qf[ks] = __builtin_bit_cast(bf16x8, a);
          const float f[8] = {bflo(a.x), bfhi(a.x), bflo(a.y), bfhi(a.y), bflo(a.z), bfhi(a.z), bflo(a.w), bfhi(a.w)};
          const LAS float* nsp = sc + 384 + 32 * ks + 8 * g;
#pragma unroll
          for (int j = 0; j < 8; ++j) qd += f[j] * nsp[j];
          v4u o; o.x = pk2(f[0] * einter, f[1] * einter); o.y = pk2(f[2] * einter, f[3] * einter); o.z = pk2(f[4] * einter, f[5] * einter); o.w = pk2(f[6] * einter, f[7] * einter);
          qs[ks] = __builtin_bit_cast(bf16x8, o); } }
    qd += __shfl_xor(qd, 16); qd += __shfl_xor(qd, 32);
    f32x4 S[8]; float psum = 0.f;
#pragma unroll
    for (int st = 0; st < 8; ++st) S[st] = (f32x4){0.f, 0.f, 0.f, 0.f};
#pragma unroll
    for (int bt = 0; bt < 4; ++bt) {
        if (2 * bt <= wave) {
            bf16x8 kfr[2][4];
#pragma unroll
            for (int t4 = 0; t4 < 2; ++t4) { const bf16* kp = QKC + (size_t)(m0 + 16 * (2 * bt + t4) + li) * 1024 + 512 + hh * 128 + 8 * g;
#pragma unroll
                for (int ks = 0; ks < 4; ++ks) kfr[t4][ks] = *(const bf16x8*)(kp + 32 * ks); }
#pragma unroll
            for (int t4 = 0; t4 < 2; ++t4) { const int st = 2 * bt + t4;
#pragma unroll
                for (int ks = 0; ks < 4; ++ks) S[st] = MFMA16(kfr[t4][ks], qf[ks], S[st]);
#pragma unroll
                for (int e = 0; e < 4; ++e) { const int s = 16 * st + 4 * g + e; const float wgt = (s <= q) ? expf(sc[s] - Mq) : 0.f; const float pv = S[st][e] * wgt; S[st][e] = pv; psum += pv; } }
        }
    }
    psum += __shfl_xor(psum, 16); psum += __shfl_xor(psum, 32);
    const float den = einter * qd + psum;
    const float inv = 1.f / fmaxf(fabsf(den), expf(-(sc[256 + q] + Mq)));
    bf16x8 pf[4];
#pragma unroll
    for (int s2 = 0; s2 < 4; ++s2) { v4u w; w.x = pk2(S[2 * s2][0], S[2 * s2][1]); w.y = pk2(S[2 * s2][2], S[2 * s2][3]); w.z = pk2(S[2 * s2 + 1][0], S[2 * s2 + 1][1]); w.w = pk2(S[2 * s2 + 1][2], S[2 * s2 + 1][3]);
        pf[s2] = __builtin_bit_cast(bf16x8, w); }
    f32x4 acc[16];
    const LAS bf16* csb = Cs + li * 136 + 8 * g;
#pragma unroll
    for (int vt = 0; vt < 16; ++vt) {
        f32x4 a = {0.f, 0.f, 0.f, 0.f};
#pragma unroll
        for (int ks = 0; ks < 4; ++ks) a = MFMA16(*(const LAS bf16x8*)(csb + vt * 16 * 136 + 32 * ks), qs[ks], a);
        acc[vt] = a;
    }
#pragma unroll
    for (int s2 = 0; s2 < 4; ++s2) {
        if (2 * s2 <= wave) {
#pragma unroll
            for (int vt = 0; vt < 16; ++vt) { const LAS bf16* p = Vs + (32 * s2 + 4 * g + (li >> 2)) * 264 + 16 * vt + 4 * (li & 3);
                acc[vt] = MFMA16(mk8(tr_read(p), tr_read(p + 16 * 264)), pf[s2], acc[vt]); }
        }
    }
#pragma unroll
    for (int vt = 0; vt < 16; ++vt) acc[vt] = acc[vt] * inv;
    float ssq = 0.f;
#pragma unroll
    for (int vt = 0; vt < 16; ++vt) ssq += (acc[vt][0] * acc[vt][0] + acc[vt][1] * acc[vt][1]) + (acc[vt][2] * acc[vt][2] + acc[vt][3] * acc[vt][3]);
    ssq += __shfl_xor(ssq, 16); ssq += __shfl_xor(ssq, 32);
    const float rstd = rsqrtf(ssq * (1.f / 256.f) + EPS);
    const bf16* mo = PROJ + (size_t)(m0 + q) * NPROJ + C_MO + hh * 256 + 4 * g;
    bf16* dst = MIXED + (size_t)(m0 + q) * DM + 1024 + hh * 256 + 4 * g;
    const float* hw = h_norm_w + l * 1024 + hh * 256 + 4 * g;
#pragma unroll
    for (int vt = 0; vt < 16; ++vt) { const v2u og = *(const v2u*)(mo + 16 * vt); const f32x4 w = *(const f32x4*)(hw + 16 * vt);
        v2u o; o.x = pk2(acc[vt][0] * rstd * w.x * sigmoidf_(bflo(og.x)), acc[vt][1] * rstd * w.y * sigmoidf_(bfhi(og.x)));
        o.y = pk2(acc[vt][2] * rstd * w.z * sigmoidf_(bflo(og.y)), acc[vt][3] * rstd * w.w * sigmoidf_(bfhi(og.y)));
        *(v2u*)(dst + 16 * vt) = o; }
    __syncthreads();
}

namespace pg8 {
struct EpiRes {
    static constexpr bool PERM = true, AFTER_DRAIN = false;
    const float* xin_f; const bf16_t* xin_b; bf16_t* xout; const float* gate;
    __device__ __forceinline__ void operator()(const f32x4 (&acc)[2][2][4][2], const Unit& u, int wr, int wc, int fr, int fq) const {
        const int row0 = u.pm * BM + wr * 64 + fr, col0 = u.pn * BM + wc * 32 + 8 * fq, b = (u.pm * BM) >> 12;
        f32x4 gv[2][2];
#pragma unroll
        for (int bj = 0; bj < 2; ++bj)
#pragma unroll
            for (int n = 0; n < 2; ++n) gv[bj][n] = *(const f32x4*)(gate + (size_t)b * 12288 + col0 + bj * HALF + 4 * n);
#pragma unroll
        for (int am = 0; am < 4; ++am) {
            const int ai = am >> 1, mb = (am & 1) * 2;
            f32x4 xr[2][2][2];
            if (xin_f) {
#pragma unroll
                for (int m = 0; m < 2; ++m)
#pragma unroll
                    for (int bj = 0; bj < 2; ++bj)
#pragma unroll
                        for (int n = 0; n < 2; ++n) xr[m][bj][n] = *(const f32x4*)(xin_f + (size_t)(row0 + ai * HALF + (mb + m) * 16) * 2048 + col0 + bj * HALF + 4 * n);
            } else {
#pragma unroll
                for (int m = 0; m < 2; ++m)
#pragma unroll
                    for (int bj = 0; bj < 2; ++bj) { const u32x4 w = *(const u32x4*)(xin_b + (size_t)(row0 + ai * HALF + (mb + m) * 16) * 2048 + col0 + bj * HALF);
                        xr[m][bj][0] = (f32x4){__builtin_bit_cast(float, w.x << 16), __builtin_bit_cast(float, w.x & 0xffff0000u), __builtin_bit_cast(float, w.y << 16), __builtin_bit_cast(float, w.y & 0xffff0000u)};
                        xr[m][bj][1] = (f32x4){__builtin_bit_cast(float, w.z << 16), __builtin_bit_cast(float, w.z & 0xffff0000u), __builtin_bit_cast(float, w.w << 16), __builtin_bit_cast(float, w.w & 0xffff0000u)}; }
            }
#pragma unroll
            for (int m = 0; m < 2; ++m)
#pragma unroll
                for (int bj = 0; bj < 2; ++bj) { const f32x4 v0 = xr[m][bj][0] + gv[bj][0] * acc[ai][bj][mb + m][0], v1 = xr[m][bj][1] + gv[bj][1] * acc[ai][bj][mb + m][1];
                    u32x4 w; w.x = cvt_pk_bf16(v0[0], v0[1]); w.y = cvt_pk_bf16(v0[2], v0[3]); w.z = cvt_pk_bf16(v1[0], v1[1]); w.w = cvt_pk_bf16(v1[2], v1[3]);
                    *(u32x4*)(xout + (size_t)(row0 + ai * HALF + (mb + m) * 16) * 2048 + col0 + bj * HALF) = w; }
        }
    }
};
struct EpiProj {
    static constexpr bool PERM = true, AFTER_DRAIN = false;
    bf16_t* O; bf16_t* VHp;
    __device__ __forceinline__ void operator()(const f32x4 (&acc)[2][2][4][2], const Unit& u, int wr, int wc, int fr, int fq) const {
        const int row0 = u.pm * BM + wr * 64 + fr, col0 = u.pn * BM + wc * 32 + 8 * fq;
        const bool isv = (u.pn >= 8 && u.pn < 12);
#pragma unroll
        for (int ai = 0; ai < 2; ++ai)
#pragma unroll
            for (int m = 0; m < 4; ++m) { const int row = row0 + ai * HALF + m * 16;
#pragma unroll
                for (int bj = 0; bj < 2; ++bj) { const f32x4 v0 = acc[ai][bj][m][0], v1 = acc[ai][bj][m][1]; const int col = col0 + bj * HALF;
                    u32x4 w; w.x = cvt_pk_bf16(v0[0], v0[1]); w.y = cvt_pk_bf16(v0[2], v0[3]); w.z = cvt_pk_bf16(v1[0], v1[1]); w.w = cvt_pk_bf16(v1[2], v1[3]);
                    bf16_t* dst = isv ? VHp + ((size_t)((row >> 12) * 16 + ((col - 2048) >> 6)) * 4096 + (row & 4095)) * 64 + (col & 63) : O + (size_t)row * 6144 + col;
                    *(u32x4*)dst = w; } }
    }
};
struct EpiGlu {
    static constexpr bool PERM = true, AFTER_DRAIN = false;
    bf16_t* act;
    __device__ __forceinline__ void operator()(const f32x4 (&acc)[2][2][4][2], const Unit& u, int wr, int wc, int fr, int fq) const {
        const int row0 = u.pm * BM + wr * 64 + fr, col0 = (u.pn & 7) * 128 + wc * 32 + 8 * fq;
#pragma unroll
        for (int ai = 0; ai < 2; ++ai)
#pragma unroll
            for (int m = 0; m < 4; ++m) {
                float o[8];
#pragma unroll
                for (int n = 0; n < 2; ++n)
#pragma unroll
                    for (int j = 0; j < 4; ++j) { const float gt = acc[ai][0][m][n][j], up = acc[ai][1][m][n][j]; o[4 * n + j] = gt / (1.f + __expf(-gt)) * up; }
                u32x4 w; w.x = cvt_pk_bf16(o[0], o[1]); w.y = cvt_pk_bf16(o[2], o[3]); w.z = cvt_pk_bf16(o[4], o[5]); w.w = cvt_pk_bf16(o[6], o[7]);
                *(u32x4*)(act + (size_t)(row0 + ai * HALF + m * 16) * 1024 + col0) = w; }
    }
};
struct MoeOrder {
    int nunits, G, c; const PG8_LAS unsigned char* tile_e;
    __device__ __forceinline__ bool next(int i, Unit& u) const { const int L = i * G + c; if (L >= nunits) return false; const int rt = L >> 3; u.pm = rt; u.pn = (int)tile_e[rt] * 8 + (L & 7); return true; }
    __device__ __forceinline__ void a_ready(const Unit&) const {}
    __device__ __forceinline__ void done(const Unit&) const {}
};
}


#ifndef GEMM_ALIGN
#define GEMM_ALIGN false
#endif
#ifndef GEMM_ALIGN_IN
#define GEMM_ALIGN_IN GEMM_ALIGN
#endif
#ifndef GEMM_ALIGN_OUT
#define GEMM_ALIGN_OUT GEMM_ALIGN
#endif
#ifndef GEMM_ALIGN_UP
#define GEMM_ALIGN_UP GEMM_ALIGN
#endif
#ifndef GEMM_ALIGN_DN
#define GEMM_ALIGN_DN GEMM_ALIGN
#endif
__device__ __forceinline__ void gemm_in(LAS unsigned char* lds, const bf16* A, const bf16* Bt, bf16* O, bf16* VHp, int G, int bx) {
    pg8::Gemm g{A, Bt, T, NPROJ, DM}; pg8::StaticOrder S; S.init(T, NPROJ, G, bx);
    pg8::EpiProj E{O, VHp};
    pg8::gemm_phase<pg8::EpiProj, pg8::StaticOrder, GEMM_ALIGN_IN, true>(lds, g, S, E);
}
__device__ __forceinline__ void gemm_out(LAS unsigned char* lds, const bf16* A, const bf16* Bt, const float* xin_f, const bf16* xin_b, bf16* xout, const float* gate, int G, int bx) {
    pg8::Gemm g{A, Bt, T, DM, DM}; pg8::StaticOrder S; S.init(T, DM, G, bx);
    pg8::EpiRes E{xin_f, xin_b, xout, gate};
    pg8::gemm_phase<pg8::EpiRes, pg8::StaticOrder, GEMM_ALIGN_OUT, true>(lds, g, S, E);
}
__device__ __forceinline__ void gemm_up(LAS unsigned char* lds, const bf16* A, const int* rowtok, const bf16* Bt, bf16* act, int nt, int G, int bx) {
    pg8::MoeOrder S{nt * 8, G, bx, (const LAS unsigned char*)(lds + LDS_TILE)};
    pg8::Gemm g{A, Bt, HS_ROWS, NEXP * 2048, DM, rowtok};
    pg8::EpiGlu E{act};
    pg8::gemm_phase<pg8::EpiGlu, pg8::MoeOrder, GEMM_ALIGN_UP, true, true>(lds, g, S, E);
}
__device__ __forceinline__ void gemm_down(LAS unsigned char* lds, const bf16* A, const bf16* Bt, bf16* O, int nt, int G, int bx) {
    pg8::MoeOrder S{nt * 8, G, bx, (const LAS unsigned char*)(lds + LDS_TILE)};
    pg8::Gemm g{A, Bt, HS_ROWS, NEXP * 2048, FFE};
    pg8::EpiBf16<0> E{O, DM, nullptr, 2048, 0, 1.f};
    pg8::gemm_phase<pg8::EpiBf16<0>, pg8::MoeOrder, GEMM_ALIGN_DN, true>(lds, g, S, E);
}

constexpr int PH_PER_LAYER = 11, N_PHASES = 1 + NLAYER * PH_PER_LAYER + 1;
struct Args { const float* in[21]; float* out; unsigned char* ws; int ph_lo, ph_hi; };
__global__ void __launch_bounds__(NTHR, 2) fwd(Args args) {
    extern __shared__ __attribute__((aligned(16))) unsigned char lds_raw[];
    LAS unsigned char* lds = (LAS unsigned char*)lds_raw;
    const int tid = threadIdx.x;
    const int G = gridDim.x, bx = blockIdx.x, vcu = (G % 8 == 0) ? (bx % 8) * (G / 8) + bx / 8 : bx;
#define KAS __attribute__((address_space(4)))
#define P_IN(i) (*(const float* const KAS*)(ka + 8 * (i)))
#define P_WS (*(unsigned char* const KAS*)(ka + 176))
#define P_X (*(float* const KAS*)(ka + 168))
#define P_F(off) ((float*)(P_WS + (off)))
#define P_I(off) ((int*)(P_WS + (off)))
#define P_B(off) ((bf16*)(P_WS + (off)))
#define x_in P_IN(0)
#define cvec P_IN(1)
#define rel_bias P_IN(2)
#define w_mod P_IN(3)
#define b_mod P_IN(4)
#define norm1_w P_IN(5)
#define norm2_w P_IN(6)
#define w_in P_IN(7)
#define q_norm_w P_IN(8)
#define k_norm_w P_IN(9)
#define conv_w P_IN(10)
#define gate_b P_IN(11)
#define h_norm_w P_IN(12)
#define w_out P_IN(13)
#define rgw P_IN(14)
#define rgb P_IN(15)
#define rew P_IN(16)
#define reb P_IN(17)
#define w_gate P_IN(18)
#define w_up P_IN(19)
#define w_down P_IN(20)
#define X P_X
#define MOD P_F(WS_MOD)
#define GATES P_F(WS_GATES)
#define BCUM P_F(WS_BCUM)
#define CG P_F(WS_SMALL + SM_CG)
#define CM P_F(WS_SMALL + SM_CM)
#define MS P_F(WS_SMALL + SM_MS)
#define HIST P_I(WS_SMALL + SM_HIST)
#define TILE P_I(WS_SMALL + SM_TILE)
#define WRT P_F(WS_SMALL + SM_WRT)
#define BTG P_F(WS_SMALL + SM_BTG)
#define TOKE P_I(WS_TOK + TK_E)
#define TOKW P_F(WS_TOK + TK_W)
#define TOKR P_I(WS_TOK + TK_R)
#define TOKD P_I(WS_TOK + TK_D)
#define NLOC P_F(WS_NLOC)
#define NS P_F(WS_NS)
#define WIN P_B(WS_WIN)
#define WOUT P_B(WS_WOUT)
#define WGU P_B(WS_WGU)
#define WD P_B(WS_WD)
#define H P_B(WS_H)
#define PROJ P_B(WS_PROJ)
#define QKC P_B(WS_QKC)
#define MIXED P_B(WS_MIXED)
#define CL P_F(WS_CL)
#define CS P_B(WS_CS)
#define HS P_B(WS_HS)
#define ACT P_B(WS_ACT)
#define OROWS P_B(WS_OROWS)
#define ROWTOK P_I(WS_ROWTOK)
#define KH P_B(WS_KH)
#define VH P_B(WS_VH)
#define QN P_B(WS_QN)
#define XB P_B(WS_XB)
    if (tid < 4) ((LAS unsigned*)(lds + LDS_BARW))[tid] = 0u;
    __syncthreads();
    const int lo = args.ph_lo, hi = args.ph_hi;
    XcdBarrier bar; bar.bar = (unsigned*)(args.ws + WS_CTL) + CW_BAR; bar.x = 0; bar.st = nullptr;
    if (hi - lo > 1) bar = xcd_barrier_post((unsigned*)(args.ws + WS_CTL) + CW_BAR, (volatile LAS unsigned*)(lds + LDS_BARW));
#ifndef ENMASK
#define ENMASK 0xFFF
#endif
#define EN(j) ((ENMASK >> (j)) & 1)
#ifndef REPMASK
#define REPMASK 0
#endif
#ifndef REPL0
#define REPL0 0
#endif
#define NREP(j) ((((REPMASK >> (j)) & 1) || (((REPL0 >> (j)) & 1) && l == 0)) ? 2 : 1)
#define IN(k) (lo <= (k) && (k) < hi)
#define PTID int tp = tid; asm volatile("" : "+v"(tp)); const KAS char* ka = (const KAS char*)__builtin_amdgcn_kernarg_segment_ptr(); asm volatile("" : "+s"(ka))
#define SEAM(k) do { if ((k) + 1 < hi) xcd_barrier(bar); } while (0)

    if (EN(11) && IN(0)) {
        PTID;
        for (int rep_ = 0; rep_ < (((REPMASK >> 11) & 1) ? 2 : 1); ++rep_) {
        p0_mod(cvec, w_mod, b_mod, MOD, lds, vcu, G, tp);
        p0_convert(w_in, w_out, w_gate, w_up, w_down, rgw, rew, WRT, rel_bias, BTG, WIN, WOUT, WGU, WD, lds, vcu, G, tp); if (rep_ == 0 && ((REPMASK >> 11) & 1)) __syncthreads(); }
        SEAM(0);
    }
#pragma unroll 1
    for (int l = 0; l < NLAYER; ++l) {
        const int pb = 1 + PH_PER_LAYER * l;
        if (EN(0) && IN(pb + 0)) {
            PTID;
for (int rep_ = 0; rep_ < NREP(0); ++rep_) { phase_a(l == 0 ? 0 : 1, l, x_in, XB, X, MOD, norm1_w, w_in, gate_b, TOKD, TOKW, OROWS, H, GATES, lds, vcu, G, tp); if (NREP(0) > 1) __syncthreads(); }
            SEAM(pb + 0);
        }
        if (EN(1) && IN(pb + 1)) {
            PTID;
for (int rep_ = 0; rep_ < NREP(1); ++rep_) { gemm_in(lds, H, WIN + (size_t)l * NPROJ * DM, PROJ, VH, G, bx); if (NREP(1) > 1) __syncthreads(); }
            SEAM(pb + 1);
        }
        if (EN(2) && IN(pb + 2)) {
            PTID;
            for (int rep_ = 0; rep_ < NREP(2); ++rep_) phase_c0(l, PROJ, QKC, KH, QN, q_norm_w, k_norm_w, conv_w, vcu, G, tp);
            SEAM(pb + 2);
        }
        if (EN(3) && IN(pb + 3)) {
            PTID;
#ifdef ATT_PROBE
            for (int un = vcu; un < NB * 16 * 16; un += G) attn_unit<ATT_PROBE>(un >> 8, (un >> 4) & 15, un & 15, QN, KH, VH, MIXED, BTG, lds, tp);
#endif
            for (int rep_ = 0; rep_ < (((REPMASK >> 12) & 1) ? 2 : 1); ++rep_)
            if (!((ENMASK >> 14) & 1))
            for (int un = vcu; un < NB * 16 * 16; un += G) attn_unit<0>(un >> 8, (un >> 4) & 15, un & 15, QN, KH, VH, MIXED, BTG, lds, tp);
            for (int rep_ = 0; rep_ < (((REPMASK >> 13) & 1) ? 2 : 1); ++rep_)
            if (!((ENMASK >> 15) & 1))
            for (int un = vcu; un < 512; un += G) mlstm_local_unit(un, PROJ, QKC, GATES, BCUM, CG, CM, CL, NLOC, lds, tp);
            SEAM(pb + 3);
        }
        if (EN(4) && IN(pb + 4)) {
            PTID;
for (int rep_ = 0; rep_ < NREP(4); ++rep_) { phase_d(CG, CM, MS, CL, CS, NLOC, NS, lds, vcu, G, tp); if (NREP(4) > 1) __syncthreads(); }
            SEAM(pb + 4);
        }
        if (EN(5) && IN(pb + 5)) {
            PTID;
for (int rep_ = 0; rep_ < NREP(5); ++rep_) { for (int un = vcu; un < 512; un += G) mlstm_out_unit(l, un, PROJ, QKC, GATES, BCUM, MS, CS, NS, h_norm_w, MIXED, lds, tp); if (NREP(5) > 1) __syncthreads(); }
            SEAM(pb + 5);
        }
        if (EN(6) && IN(pb + 6)) {
            PTID;
for (int rep_ = 0; rep_ < NREP(6); ++rep_) { gemm_out(lds, MIXED, WOUT + (size_t)l * DM * DM, l == 0 ? x_in : (const float*)nullptr, XB, XB, MOD + (size_t)l * NB * MODW + 2 * DM, G, bx); if (NREP(6) > 1) __syncthreads(); }
            SEAM(pb + 6);
        }
        if (EN(7) && IN(pb + 7)) {
            PTID;
for (int rep_ = 0; rep_ < NREP(7); ++rep_) { phase_g(l, XB, MOD, norm2_w, rgw + (size_t)l * DM * 4, rgb + l * 4, rew + (size_t)l * DM * 32, reb + l * 32, WRT, H, TOKE, TOKW, TOKR, HIST, lds, vcu, G, tp); if (NREP(7) > 1) __syncthreads(); }
            SEAM(pb + 7);
        }
        if (EN(8) && IN(pb + 8)) {
            PTID;
for (int rep_ = 0; rep_ < NREP(8); ++rep_) { phase_h0(HIST, TOKE, TOKR, TOKD, ROWTOK, TILE, lds, vcu, G, tp); if (NREP(8) > 1) __syncthreads(); }
            SEAM(pb + 8);
        }
        if ((EN(9) || EN(10)) && (IN(pb + 9) || IN(pb + 10))) {
            PTID;
            const int nt = TILE[0];
            for (int i = tp; i < MAXTILES; i += NTHR) ((LAS unsigned char*)(lds + LDS_TILE))[i] = (unsigned char)(i < nt ? TILE[1 + i] : 0);
            __syncthreads();
            if (EN(9) && IN(pb + 9)) {
for (int rep_ = 0; rep_ < NREP(9); ++rep_) { gemm_up(lds, H, ROWTOK, WGU + (size_t)l * NEXP * 2048 * DM, ACT, nt, G, bx); if (NREP(9) > 1) __syncthreads(); }
                SEAM(pb + 9);
            }
            if (EN(10) && IN(pb + 10)) {
for (int rep_ = 0; rep_ < NREP(10); ++rep_) { gemm_down(lds, ACT, WD + (size_t)l * NEXP * DM * FFE, OROWS, nt, G, bx); if (NREP(10) > 1) __syncthreads(); }
                SEAM(pb + 10);
            }
        }
    }
    if (IN(N_PHASES - 1)) {
        PTID;
        phase_a(2, NLAYER, x_in, XB, X, MOD, norm1_w, w_in, gate_b, TOKD, TOKW, OROWS, H, GATES, lds, vcu, G, tp);
    }
#undef IN
#undef SEAM
#undef x_in
#undef cvec
#undef rel_bias
#undef w_mod
#undef b_mod
#undef norm1_w
#undef norm2_w
#undef w_in
#undef q_norm_w
#undef k_norm_w
#undef conv_w
#undef gate_b
#undef h_norm_w
#undef w_out
#undef rgw
#undef rgb
#undef rew
#undef reb
#undef w_gate
#undef w_up
#undef w_down
#undef X
#undef MOD
#undef GATES
#undef BCUM
#undef CG
#undef CM
#undef MS
#undef HIST
#undef TILE
#undef WRT
#undef BTG
#undef TOKE
#undef TOKW
#undef TOKR
#undef TOKD
#undef NLOC
#undef NS
#undef WIN
#undef WOUT
#undef WGU
#undef WD
#undef H
#undef PROJ
#undef QKC
#undef MIXED
#undef CL
#undef CS
#undef HS
#undef ACT
#undef OROWS
#undef ROWTOK
#undef KH
#undef VH
#undef QN
#undef XB
}

#ifndef MK_SPLIT
#define MK_SPLIT 0
#endif
extern "C" void kernel_launch(void* const* d_in, const int* in_sizes, int n_in, void* d_out, int out_size, void* d_ws, size_t ws_size, hipStream_t stream) {
    static int grid = 0;
    if (grid == 0) {
        if (n_in != 21 || out_size != T * DM || ws_size < WS_END) { fprintf(stderr, "kernel_launch: unexpected shapes (n_in %d, out %d, ws %zu)\n", n_in, out_size, ws_size); grid = -1; return; }
        int dev = 0, cus = 0, per_cu = 0;
        if (hipGetDevice(&dev) != hipSuccess || hipDeviceGetAttribute(&cus, hipDeviceAttributeMultiprocessorCount, dev) != hipSuccess) { grid = -1; return; }
        if (hipFuncSetAttribute((const void*)fwd, hipFuncAttributeMaxDynamicSharedMemorySize, LDS_BYTES) != hipSuccess) { fprintf(stderr, "kernel_launch: hipFuncSetAttribute failed\n"); grid = -1; return; }
        if (hipOccupancyMaxActiveBlocksPerMultiprocessor(&per_cu, (const void*)fwd, NTHR, LDS_BYTES) != hipSuccess || per_cu < 1) { fprintf(stderr, "kernel_launch: occupancy query says %d\n", per_cu); }
        (void)hipGetLastError();
        grid = 1; while (grid * 2 <= cus) grid *= 2;
    }
    if (grid < 0) return;
    if (hipMemsetAsync((char*)d_ws + WS_CTL, 0, CTL_ZERO_BYTES, stream) != hipSuccess) return;
    Args a{};
    for (int i = 0; i < 21; ++i) a.in[i] = (const float*)d_in[i];
    a.out = (float*)d_out; a.ws = (unsigned char*)d_ws;
#if MK_SPLIT
    for (int p = 0; p < N_PHASES; ++p) { a.ph_lo = p; a.ph_hi = p + 1; hipLaunchKernelGGL(fwd, dim3(grid), dim3(NTHR), LDS_BYTES, stream, a); }
#else
    a.ph_lo = 0; a.ph_hi = N_PHASES;
    hipLaunchKernelGGL(fwd, dim3(grid), dim3(NTHR), LDS_BYTES, stream, a);
#endif
}
```
